# Optimizing an MI355X kernel written in HIP

```python
import math
import jax, jax.numpy as jnp
from jax import lax
import numpy as np

D_MODEL = 1024
BATCH = 16
SEQ = 2048
DEPTH = 2

D_RNN = D_MODEL
RNN_BLOCKS = 8
RNN_BLOCK_W = D_RNN // RNN_BLOCKS
CONV_RNN = 4
RG_LRU_C = 8.0
DIFF_HEADS = 4
DIFF_HEAD_DIM = 64
DIFF_QK = DIFF_HEADS * 2 * DIFF_HEAD_DIM
DIFF_WIDTH = DIFF_HEADS * 2 * DIFF_HEAD_DIM
FOX_HEADS = 8
FOX_HEAD_DIM = 64
FOX_WIDTH = FOX_HEADS * FOX_HEAD_DIM
N_BUCKETS = 32
MAX_EXACT = N_BUCKETS // 2
MAX_DISTANCE = 128
Q_BLOCK = 128
D_FF = ((8 * D_MODEL // 3 + 127) // 128) * 128
CONV_FFN = 3
N_BRANCH = 3
EPS = 1e-6

IN_WIDTHS = (D_RNN, D_RNN, DIFF_QK, DIFF_QK, DIFF_WIDTH, FOX_WIDTH, FOX_WIDTH, FOX_WIDTH, FOX_HEADS, N_BRANCH * D_MODEL)
N_IN = int(sum(IN_WIDTHS))
IN_SPLITS = tuple(int(v) for v in np.cumsum(IN_WIDTHS)[:-1])

kernel_name = "hybrid_rglru_diffattn_fox_gated_trunk"


def rmsnorm(x, g):
    xf = x.astype(jnp.float32)
    y = xf * lax.rsqrt(jnp.mean(xf * xf, axis=-1, keepdims=True) + EPS)
    return (y * g.astype(jnp.float32)).astype(x.dtype)


def causal_dwconv(x, w, b):
    k = w.shape[0]
    s = x.shape[1]
    xp = jnp.pad(x, ((0, 0), (k - 1, 0), (0, 0)))
    y = b + xp[:, 0:s] * w[0]
    for j in range(1, k):
        y = y + xp[:, j:j + s] * w[j]
    return y


def _to_blocks(t):
    b, s = t.shape[:2]
    return jnp.moveaxis(t.reshape(b, s // Q_BLOCK, Q_BLOCK, *t.shape[2:]), 1, 0)


def _from_blocks(t):
    nb, b = t.shape[:2]
    t = jnp.moveaxis(t, 0, 1)
    return t.reshape(b, nb * Q_BLOCK, *t.shape[3:])


def t5_bucket(dist):
    n = jnp.maximum(dist, 0)
    nf = jnp.maximum(n, 1).astype(jnp.float32)
    large = MAX_EXACT + (jnp.log(nf / MAX_EXACT) / math.log(MAX_DISTANCE / MAX_EXACT)
                         * (N_BUCKETS - MAX_EXACT)).astype(jnp.int32)
    large = jnp.minimum(large, N_BUCKETS - 1)
    return jnp.where(n < MAX_EXACT, n, large)


def rg_lru(x, w_r, b_r, w_i, b_i, a_param):
    bsz, s, c = x.shape
    xb = x.reshape(bsz, s, RNN_BLOCKS, RNN_BLOCK_W)
    r = jax.nn.sigmoid(jnp.einsum('bsnc,ncd->bsnd', xb, w_r).reshape(bsz, s, c) + b_r)
    i = jax.nn.sigmoid(jnp.einsum('bsnc,ncd->bsnd', xb, w_i).reshape(bsz, s, c) + b_i)
    log_a = (-RG_LRU_C * r.astype(jnp.float32)) * jax.nn.softplus(-a_param.astype(jnp.float32))
    a = jnp.exp(log_a)
    u = jnp.sqrt(-jnp.expm1(2.0 * log_a)) * (i * x).astype(jnp.float32)

    def combine(left, right):
        a1, b1 = left
        a2, b2 = right
        return a1 * a2, a2 * b1 + b2

    _, h = lax.associative_scan(combine, (a, u), axis=1)
    return h.astype(x.dtype)


def diff_attention(q, k, v, lam, rel_table):
    s_len = q.shape[1]
    scale = DIFF_HEAD_DIM ** -0.5
    k_pos = jnp.arange(s_len)

    def one_block(args):
        qb, blk = args
        q_pos = blk * Q_BLOCK + jnp.arange(Q_BLOCK)
        dist = q_pos[:, None] - k_pos[None, :]
        bias = jnp.moveaxis(rel_table[t5_bucket(dist)], -1, 0)
        sc = jnp.einsum('bqhcd,bkhcd->bchqk', qb, k).astype(jnp.float32) * scale + bias.astype(jnp.float32)
        sc = jnp.where(dist >= 0, sc, -jnp.inf)
        p = jax.nn.softmax(sc, axis=-1)
        w = p[:, 0] - lam * p[:, 1]
        return jnp.einsum('bhqk,bkhd->bqhd', w.astype(v.dtype), v)

    out = lax.map(one_block, (_to_blocks(q), jnp.arange(s_len // Q_BLOCK)))
    return _from_blocks(out)


def forgetting_attention(q, k, v, log_f):
    s_len = q.shape[1]
    scale = FOX_HEAD_DIM ** -0.5
    k_pos = jnp.arange(s_len)
    c = jnp.cumsum(log_f.astype(jnp.float32), axis=1)
    ck = jnp.moveaxis(c, -1, 1)

    def one_block(args):
        qb, cq, blk = args
        q_pos = blk * Q_BLOCK + jnp.arange(Q_BLOCK)
        dist = q_pos[:, None] - k_pos[None, :]
        decay = jnp.moveaxis(cq, -1, 1)[..., None] - ck[:, :, None, :]
        sc = jnp.einsum('bqhd,bkhd->bhqk', qb, k).astype(jnp.float32) * scale + decay
        sc = jnp.where(dist >= 0, sc, -jnp.inf)
        p = jax.nn.softmax(sc, axis=-1)
        return jnp.einsum('bhqk,bkhd->bqhd', p.astype(v.dtype), v)

    out = lax.map(one_block, (_to_blocks(q), _to_blocks(c), jnp.arange(s_len // Q_BLOCK)))
    return _from_blocks(out)


def setup_inputs(seed: int = 0) -> dict:
    key = jax.random.key(seed)
    ks = jax.random.split(key, 32)
    L = DEPTH

    def nrm(k, shape, scale):
        return jax.random.normal(k, shape, jnp.float32) * scale

    a_target = jax.random.uniform(ks[9], (L, D_RNN), jnp.float32, 0.9, 0.999)
    sig = a_target ** (1.0 / RG_LRU_C)
    return {
        "x": nrm(ks[0], (BATCH, SEQ, D_MODEL), 1.0),
        "norm1_g": 1.0 + nrm(ks[1], (L, D_MODEL), 0.02),
        "w_in": nrm(ks[2], (L, D_MODEL, N_IN), D_MODEL ** -0.5),
        "rnn_conv_w": nrm(ks[3], (L, CONV_RNN, D_RNN), CONV_RNN ** -0.5),
        "rnn_conv_b": nrm(ks[4], (L, D_RNN), 0.02),
        "rg_w_r": nrm(ks[5], (L, RNN_BLOCKS, RNN_BLOCK_W, RNN_BLOCK_W), RNN_BLOCK_W ** -0.5),
        "rg_b_r": nrm(ks[6], (L, D_RNN), 0.02),
        "rg_w_i": nrm(ks[7], (L, RNN_BLOCKS, RNN_BLOCK_W, RNN_BLOCK_W), RNN_BLOCK_W ** -0.5),
        "rg_b_i": nrm(ks[8], (L, D_RNN), 0.02),
        "rg_a": jnp.log(sig) - jnp.log1p(-sig),
        "diff_lq1": nrm(ks[10], (L, DIFF_HEAD_DIM), 0.1),
        "diff_lk1": nrm(ks[11], (L, DIFF_HEAD_DIM), 0.1),
        "diff_lq2": nrm(ks[12], (L, DIFF_HEAD_DIM), 0.1),
        "diff_lk2": nrm(ks[13], (L, DIFF_HEAD_DIM), 0.1),
        "diff_subln_g": 1.0 + nrm(ks[14], (L, 2 * DIFF_HEAD_DIM), 0.02),
        "rel_bias": nrm(ks[15], (N_BUCKETS, DIFF_HEADS), 0.5),
        "fox_b_f": 3.0 + nrm(ks[16], (L, FOX_HEADS), 0.5),
        "gate_b": nrm(ks[17], (L, N_BRANCH, D_MODEL), 0.02),
        "w_br_rnn": nrm(ks[18], (L, D_RNN, D_MODEL), D_RNN ** -0.5),
        "w_br_diff": nrm(ks[19], (L, DIFF_WIDTH, D_MODEL), DIFF_WIDTH ** -0.5),
        "w_br_fox": nrm(ks[20], (L, FOX_WIDTH, D_MODEL), FOX_WIDTH ** -0.5),
        "w_out": nrm(ks[21], (L, D_MODEL, D_MODEL), D_MODEL ** -0.5),
        "norm2_g": 1.0 + nrm(ks[22], (L, D_MODEL), 0.02),
        "ffn_up": nrm(ks[23], (L, D_MODEL, 2 * D_FF), D_MODEL ** -0.5),
        "ffn_conv_w": nrm(ks[24], (L, CONV_FFN, 2 * D_FF), CONV_FFN ** -0.5),
        "ffn_conv_b": nrm(ks[25], (L, 2 * D_FF), 0.02),
        "ffn_down": nrm(ks[26], (L, D_FF, D_MODEL), D_FF ** -0.5),
        "final_g": 1.0 + nrm(ks[27], (D_MODEL,), 0.02),
    }


def reference(x, norm1_g, w_in, rnn_conv_w, rnn_conv_b, rg_w_r, rg_b_r, rg_w_i, rg_b_i, rg_a,
              diff_lq1, diff_lk1, diff_lq2, diff_lk2, diff_subln_g, rel_bias, fox_b_f, gate_b,
              w_br_rnn, w_br_diff, w_br_fox, w_out, norm2_g, ffn_up, ffn_conv_w, ffn_conv_b,
              ffn_down, final_g):
    bsz, s_len, _ = x.shape
    for l in range(DEPTH):
        h = rmsnorm(x, norm1_g[l])
        proj = h @ w_in[l]
        (x_rnn, g_rnn, dq, dk, dv, fq, fk, fv, f_logit, gates) = jnp.split(proj, IN_SPLITS, axis=-1)

        x_rnn = causal_dwconv(x_rnn, rnn_conv_w[l], rnn_conv_b[l])
        y_rnn = jax.nn.gelu(g_rnn) * rg_lru(x_rnn, rg_w_r[l], rg_b_r[l], rg_w_i[l], rg_b_i[l], rg_a[l])

        lam_init = 0.8 - 0.6 * math.exp(-0.3 * l)
        lam = (jnp.exp(jnp.sum(diff_lq1[l] * diff_lk1[l]).astype(jnp.float32))
               - jnp.exp(jnp.sum(diff_lq2[l] * diff_lk2[l]).astype(jnp.float32)) + lam_init)
        o_diff = diff_attention(dq.reshape(bsz, s_len, DIFF_HEADS, 2, DIFF_HEAD_DIM),
                                dk.reshape(bsz, s_len, DIFF_HEADS, 2, DIFF_HEAD_DIM),
                                dv.reshape(bsz, s_len, DIFF_HEADS, 2 * DIFF_HEAD_DIM), lam, rel_bias)
        y_diff = (rmsnorm(o_diff, diff_subln_g[l]) * (1.0 - lam_init)).reshape(bsz, s_len, DIFF_WIDTH)

        log_f = jax.nn.log_sigmoid((f_logit + fox_b_f[l]).astype(jnp.float32))
        o_fox = forgetting_attention(fq.reshape(bsz, s_len, FOX_HEADS, FOX_HEAD_DIM),
                                     fk.reshape(bsz, s_len, FOX_HEADS, FOX_HEAD_DIM),
                                     fv.reshape(bsz, s_len, FOX_HEADS, FOX_HEAD_DIM), log_f)
        y_fox = o_fox.reshape(bsz, s_len, FOX_WIDTH)

        g = jax.nn.sigmoid(gates.reshape(bsz, s_len, N_BRANCH, D_MODEL) + gate_b[l])
        m = (g[:, :, 0] * (y_rnn @ w_br_rnn[l])
             + g[:, :, 1] * (y_diff @ w_br_diff[l])
             + g[:, :, 2] * (y_fox @ w_br_fox[l]))
        x = x + m @ w_out[l]

        h = rmsnorm(x, norm2_g[l])
        u = causal_dwconv(h @ ffn_up[l], ffn_conv_w[l], ffn_conv_b[l])
        u_gate, u_val = jnp.split(u, 2, axis=-1)
        x = x + (jax.nn.gelu(u_gate) * u_val) @ ffn_down[l]
    return rmsnorm(x, final_g)
```

```cpp
#include <hip/hip_runtime.h>
#include <hip/hip_cooperative_groups.h>
#include <cstdio>
#include <cstdint>
#include <cmath>
namespace cg = cooperative_groups;

#define LAS __attribute__((address_space(3)))
typedef unsigned short bf16_t;
typedef short bf16x8 __attribute__((ext_vector_type(8)));
typedef short s16x4 __attribute__((ext_vector_type(4)));
typedef float f32x4 __attribute__((ext_vector_type(4)));
typedef float f32x2 __attribute__((ext_vector_type(2)));
typedef float f32x16 __attribute__((ext_vector_type(16)));
typedef unsigned u32x4 __attribute__((ext_vector_type(4)));
typedef unsigned u32x2 __attribute__((ext_vector_type(2)));

constexpr int DM = 1024, BATCH = 16, SEQ = 2048, MTOK = BATCH * SEQ, DEPTH = 2;
constexpr int NIN = 8200, DFF = 2816, DFF2 = 5632;
constexpr int XP = 1024, QP = 512;
constexpr size_t MT = (size_t)BATCH * SEQ;
constexpr size_t O_XR = 0, O_GR = MT * XP, O_DQ = 2 * MT * XP, O_DK = O_DQ + MT * QP, O_DV = O_DK + MT * QP, O_FQ = O_DV + MT * QP, O_FK = O_FQ + MT * QP, O_FV = O_FK + MT * QP;
constexpr float LOG2E = 1.4426950408889634f;
constexpr float EPS = 1e-6f;
constexpr size_t MiB = 1u << 20;
constexpr size_t WS_WIN = 1 * MiB, WS_WBR_RNN = 17 * MiB, WS_WBR_DIFF = 19 * MiB, WS_WBR_FOX = 21 * MiB, WS_WOUT = 23 * MiB, WS_WUP = 25 * MiB,
                 WS_WDOWN = 36 * MiB, WS_RGR = 42 * MiB, WS_RGI = 42 * MiB + 256 * 1024, WS_SUMSQ = 43 * MiB, WS_C = 44 * MiB, WS_LOGF = 45 * MiB, WS_H = 46 * MiB, WS_P = 110 * MiB,
                 WS_XG = WS_P, WS_ACT = 174 * MiB, WS_HALO = 350 * MiB, WS_END = 430 * MiB;
constexpr int LDS_BYTES = 147456;
constexpr int MHALF = MTOK / 2;

__device__ __forceinline__ unsigned f2bf(float f) { unsigned u = __builtin_bit_cast(unsigned, f); return (u + 0x7fffu + ((u >> 16) & 1u)) >> 16; }
__device__ __forceinline__ unsigned pk2(float lo, float hi) { return f2bf(lo) | (f2bf(hi) << 16); }
__device__ __forceinline__ float bf2f(unsigned short b) { return __builtin_bit_cast(float, (unsigned)b << 16); }
__device__ __forceinline__ float bflo(unsigned w) { return __builtin_bit_cast(float, w << 16); }
__device__ __forceinline__ float bfhi(unsigned w) { return __builtin_bit_cast(float, w & 0xffff0000u); }
typedef __bf16 bf16x2_t __attribute__((ext_vector_type(2)));
__device__ __forceinline__ unsigned cvt_pk_bf16(float lo, float hi) { const f32x2 v = {lo, hi}; const bf16x2_t b = __builtin_convertvector(v, bf16x2_t); return __builtin_bit_cast(unsigned, b); }
__device__ __forceinline__ float fast_exp2(float x) { return __builtin_amdgcn_exp2f(x); }
__device__ __forceinline__ float fast_rcp(float x) { return __builtin_amdgcn_rcpf(x); }
__device__ __forceinline__ float fast_log2(float x) { return __builtin_amdgcn_logf(x); }
__device__ __forceinline__ float fast_rsq(float x) { return __builtin_amdgcn_rsqf(x); }
__device__ __forceinline__ float log1p_small(float e) { return e < 0.01f ? e * (1.0f - e * (0.5f - e * 0.33333334f)) : fast_log2(1.0f + e) * 0.6931471806f; }
__device__ __forceinline__ float sigmoidf_(float x) { return fast_rcp(1.0f + fast_exp2(-x * LOG2E)); }
__device__ __forceinline__ float gelu_tanh(float x) { const float t = x + 0.044715f * x * x * x; return x * fast_rcp(1.0f + fast_exp2(-2.3022082f * t)); }
__device__ __forceinline__ float wave_sum(float v) {
#pragma unroll
    for (int o = 1; o < 64; o <<= 1) v += __shfl_xor(v, o);
    return v;
}
__device__ __forceinline__ int launder_tid() { int t = threadIdx.x; asm volatile("" : "+v"(t)); return t; }
template <class T> __device__ __forceinline__ T* launder_ptr(T* p) { asm volatile("" : "+s"(p)); return p; }
__device__ __forceinline__ int crow(int r, int hi) { return (r & 3) + 8 * (r >> 2) + 4 * hi; }

namespace pg8 {
constexpr int BM = 256, BK = 64, HALF = 128, HTB = HALF * BK * 2, STAGE_BYTES = 8 * HTB, NXCD = 8, WGM = 8;
__host__ __device__ __forceinline__ int lds_byte(int r, int c) { const int st = (r >> 4) * 2 + (c >> 5), rr = r & 15, cc = c & 31, ob = rr * 64 + cc * 2; return st * 1024 + (ob ^ (((ob >> 9) & 1) << 5)); }
__host__ __device__ __forceinline__ void stage_rc(int b, int& R, int& C) { const int st = b / 1024, sb = b % 1024, swz = sb ^ (((sb >> 9) & 1) << 5); R = (st >> 1) * 16 + swz / 64; C = (st & 1) * 32 + (swz % 64) / 2; }
__host__ __device__ __forceinline__ int perm32(int rho) { const int n = rho >> 4, i = rho & 15; return 8 * (i >> 2) + 4 * n + (i & 3); }

struct Unit { int pm, pn; };
struct Gemm { const bf16_t* A; const bf16_t* Bt; int lda, ldb, M, N, K; };

struct StaticOrder {
    int nM, nN, nwg, G, c;
    __host__ __device__ void init(int M, int N, int G_, int c_) { nM = M / BM; nN = N / BM; nwg = nM * nN; G = G_; c = c_; }
    __host__ __device__ bool next(int i, Unit& u) const {
        const long L = (long)i * G + c; if (L >= nwg) return false;
        int wgid = (int)L; { const int q = nwg / NXCD, r = nwg % NXCD, xcd = wgid % NXCD, off = wgid / NXCD; wgid = (xcd < r ? xcd * (q + 1) : r * (q + 1) + (xcd - r) * q) + off; }
        const int nig = WGM * nN, gid = wgid / nig, fm = gid * WGM, gsz = (nM - fm) < WGM ? (nM - fm) : WGM;
        u.pm = fm + ((wgid % nig) % gsz); u.pn = (wgid % nig) / gsz; return true;
    }
};

template <class Epi, class Sched>
__device__ __forceinline__ void gemm_phase(LAS unsigned char* lds, const Gemm g, const Sched& S, const Epi& E) {
    const int tid = launder_tid(), wid = __builtin_amdgcn_readfirstlane(tid >> 6), lane = tid & 63, wr = wid >> 2, wc = wid & 3, fr = lane & 15, fq = lane >> 4;
    const int K = g.K, nt = K / BK;
    unsigned voffA[2], voffB[2];
#pragma unroll
    for (int i = 0; i < 2; ++i) { int R, C; stage_rc(tid * 16 + i * 8192, R, C); const int Rb = (R & ~31) + perm32(R & 31);
        voffA[i] = (unsigned)(R * g.lda + C) * 2u; voffB[i] = (unsigned)(Rb * g.ldb + C) * 2u; }
    const size_t kstep = (size_t)(BK * 2);
    const size_t hstepA = (size_t)HALF * g.lda * 2, hstepB = (size_t)HALF * g.ldb * 2;
    const size_t tstepA = 2 * hstepA, tstepB = 2 * hstepB;
    const unsigned ldsw = (unsigned)wid * 1024u;
    const int aoff = lds_byte(wr * 64 + fr, fq * 8), boff = lds_byte(wc * 32 + fr, fq * 8);
#define PG8_SA(b, h) (((b) * 2 + (h)) * HTB)
#define PG8_SB(b, h) ((4 + (b) * 2 + (h)) * HTB)
#define PG8_STAGE(bufoff, gbase, voff) do { _Pragma("unroll") for (int _i = 0; _i < 2; ++_i) \
        __builtin_amdgcn_global_load_lds((const unsigned*)((const char*)(gbase) + (voff)[_i]), (LAS unsigned*)(lds + (bufoff) + ldsw + _i * 8192), 16, 0, 0); } while (0)
#define PG8_LDA(dst, b, h) do { _Pragma("unroll") for (int m = 0; m < 4; ++m) _Pragma("unroll") for (int k = 0; k < 2; ++k) dst[m][k] = *(const LAS bf16x8*)(lds + PG8_SA(b, h) + aoff + m * 2048 + k * 1024); } while (0)
#define PG8_LDB(dst, b, h) do { _Pragma("unroll") for (int n = 0; n < 2; ++n) _Pragma("unroll") for (int k = 0; k < 2; ++k) dst[n][k] = *(const LAS bf16x8*)(lds + PG8_SB(b, h) + boff + n * 2048 + k * 1024); } while (0)
#define PG8_MMA(ai, bj, At, Bt) do { __builtin_amdgcn_s_setprio(1); _Pragma("unroll") for (int m = 0; m < 4; ++m) _Pragma("unroll") for (int n = 0; n < 2; ++n) _Pragma("unroll") for (int k = 0; k < 2; ++k) \
        acc[ai][bj][m][n] = __builtin_amdgcn_mfma_f32_16x16x32_bf16(Bt[n][k], At[m][k], acc[ai][bj][m][n], 0, 0, 0); __builtin_amdgcn_s_setprio(0); } while (0)
#define PG8_WAIT_V(n) asm volatile("s_waitcnt vmcnt(" #n ")" ::: "memory")
#define PG8_WAIT_L(n) asm volatile("s_waitcnt lgkmcnt(" #n ")" ::: "memory")
#define PG8_BAR __builtin_amdgcn_s_barrier()
#define PG8_SCHED __builtin_amdgcn_sched_barrier(0)
    Unit cur, nxt; int ui = 0;
    if (!S.next(0, cur)) return;
    f32x4 acc[2][2][4][2];
#pragma unroll
    for (int a = 0; a < 2; ++a)
#pragma unroll
        for (int b = 0; b < 2; ++b)
#pragma unroll
            for (int m = 0; m < 4; ++m)
#pragma unroll
                for (int n = 0; n < 2; ++n) acc[a][b][m][n] = (f32x4){0.f, 0.f, 0.f, 0.f};
    bf16x8 At[4][2], B0[2][2], B1[2][2];
    const char* cA = (const char*)g.A + (size_t)cur.pm * tstepA; const char* cB = (const char*)g.Bt + (size_t)cur.pn * tstepB;
    PG8_STAGE(PG8_SB(0, 0), cB, voffB); PG8_STAGE(PG8_SB(0, 1), cB + hstepB, voffB); PG8_STAGE(PG8_SA(0, 0), cA, voffA); PG8_STAGE(PG8_SA(0, 1), cA + hstepA, voffA);
    if (wr == 1) PG8_BAR;
    PG8_WAIT_V(2); PG8_BAR;
    PG8_STAGE(PG8_SB(1, 0), cB + kstep, voffB); PG8_STAGE(PG8_SA(1, 0), cA + kstep, voffA); PG8_STAGE(PG8_SB(1, 1), cB + hstepB + kstep, voffB);
    PG8_WAIT_V(6); PG8_BAR;
    for (;;) {
        const bool has_next = S.next(ui + 1, nxt);
        const char* nA = has_next ? (const char*)g.A + (size_t)nxt.pm * tstepA : cA; const char* nB = has_next ? (const char*)g.Bt + (size_t)nxt.pn * tstepB : cB;
        for (int t = 0; t < nt; t += 2) {
            const bool last = (t == nt - 2);
            const char* a1 = cA + (size_t)(t + 1) * kstep;
            const char* a2 = last ? nA : cA + (size_t)(t + 2) * kstep; const char* b2 = last ? nB : cB + (size_t)(t + 2) * kstep;
            const char* a3 = a2 + kstep; const char* b3 = b2 + kstep;
            PG8_LDB(B0, 0, 0); PG8_LDB(B1, 0, 1); PG8_SCHED; PG8_LDA(At, 0, 0); PG8_STAGE(PG8_SA(1, 1), a1 + hstepA, voffA);
            PG8_WAIT_V(8); PG8_WAIT_L(0); PG8_BAR; PG8_MMA(0, 0, At, B0); PG8_MMA(0, 1, At, B1); PG8_BAR; PG8_SCHED;
            PG8_LDA(At, 0, 1); PG8_STAGE(PG8_SB(0, 0), b2, voffB); PG8_STAGE(PG8_SB(0, 1), b2 + hstepB, voffB); PG8_STAGE(PG8_SA(0, 0), a2, voffA);
            PG8_WAIT_V(8); PG8_WAIT_L(0); PG8_BAR; PG8_MMA(1, 0, At, B0); PG8_MMA(1, 1, At, B1); PG8_BAR; PG8_SCHED;
            PG8_LDB(B0, 1, 0); PG8_LDB(B1, 1, 1); PG8_SCHED; PG8_LDA(At, 1, 0); PG8_STAGE(PG8_SA(0, 1), a2 + hstepA, voffA);
            PG8_WAIT_V(8); PG8_WAIT_L(0); PG8_BAR; PG8_MMA(0, 0, At, B0); PG8_MMA(0, 1, At, B1); PG8_BAR; PG8_SCHED;
            PG8_LDA(At, 1, 1); PG8_STAGE(PG8_SB(1, 0), b3, voffB); PG8_STAGE(PG8_SB(1, 1), b3 + hstepB, voffB); PG8_STAGE(PG8_SA(1, 0), a3, voffA);
            PG8_WAIT_V(8); PG8_WAIT_L(0); PG8_BAR; PG8_MMA(1, 0, At, B0); PG8_MMA(1, 1, At, B1); PG8_BAR; PG8_SCHED;
        }
        if (wr == 0) PG8_BAR;
        E(acc, cur, wr, wc, fr, fq);
        if (!has_next) break;
#pragma unroll
        for (int a = 0; a < 2; ++a)
#pragma unroll
            for (int b = 0; b < 2; ++b)
#pragma unroll
                for (int m = 0; m < 4; ++m)
#pragma unroll
                    for (int n = 0; n < 2; ++n) acc[a][b][m][n] = (f32x4){0.f, 0.f, 0.f, 0.f};
        cur = nxt; cA = nA; cB = nB; ++ui;
        if (wr == 1) PG8_BAR;
    }
    PG8_WAIT_V(0);
    PG8_BAR;
#undef PG8_SA
#undef PG8_SB
#undef PG8_STAGE
#undef PG8_LDA
#undef PG8_LDB
#undef PG8_MMA
#undef PG8_WAIT_V
#undef PG8_WAIT_L
#undef PG8_BAR
#undef PG8_SCHED
}

struct Gemm3 { const bf16_t* Abase; const bf16_t* Bbase; int ldb;
    __device__ __forceinline__ const bf16_t* A(int s) const { return Abase + (O_GR + (size_t)s * (O_DQ - O_GR) + (size_t)(s >> 1) * (O_FQ + O_GR - 2 * O_DQ)); }
    __device__ __forceinline__ int lda(int s) const { return s ? QP : XP; }
    __device__ __forceinline__ const bf16_t* B(int s) const { return Bbase + (size_t)s * (2u << 20) / 2; }
    __device__ __forceinline__ int nt(int s) const { return 16 >> ((s + 1) >> 1); } };
template <class Epi, class Sched>
__device__ __forceinline__ void gemm_phase3(LAS unsigned char* lds, const Gemm3 g, const Sched& S, const Epi& E) {
    const int tid = launder_tid(), wid = __builtin_amdgcn_readfirstlane(tid >> 6), lane = tid & 63, wr = wid >> 2, wc = wid & 3, fr = lane & 15, fq = lane >> 4;
    unsigned voffAx[2], voffAq[2], voffB[2];
#pragma unroll
    for (int i = 0; i < 2; ++i) { int R, C; stage_rc(tid * 16 + i * 8192, R, C); const int Rb = (R & ~31) + perm32(R & 31);
        voffAx[i] = (unsigned)(R * XP + C) * 2u; voffAq[i] = (unsigned)(R * QP + C) * 2u; voffB[i] = (unsigned)(Rb * g.ldb + C) * 2u; }
    const size_t kstep = (size_t)(BK * 2);
    const size_t hstepB = (size_t)HALF * g.ldb * 2, tstepB = 2 * hstepB;
    constexpr size_t hstepAx = (size_t)HALF * XP * 2, hstepAq = (size_t)HALF * QP * 2;
    const unsigned ldsw = (unsigned)wid * 1024u;
    const int aoff = lds_byte(wr * 64 + fr, fq * 8), boff = lds_byte(wc * 32 + fr, fq * 8);
#define PG8_SA(b, h) (((b) * 2 + (h)) * HTB)
#define PG8_SB(b, h) ((4 + (b) * 2 + (h)) * HTB)
#define PG8_STAGE(bufoff, gbase, voff) do { _Pragma("unroll") for (int _i = 0; _i < 2; ++_i) \
        __builtin_amdgcn_global_load_lds((const unsigned*)((const char*)(gbase) + (voff)[_i]), (LAS unsigned*)(lds + (bufoff) + ldsw + _i * 8192), 16, 0, 0); } while (0)
#define PG8_LDA(dst, b, h) do { _Pragma("unroll") for (int m = 0; m < 4; ++m) _Pragma("unroll") for (int k = 0; k < 2; ++k) dst[m][k] = *(const LAS bf16x8*)(lds + PG8_SA(b, h) + aoff + m * 2048 + k * 1024); } while (0)
#define PG8_LDB(dst, b, h) do { _Pragma("unroll") for (int n = 0; n < 2; ++n) _Pragma("unroll") for (int k = 0; k < 2; ++k) dst[n][k] = *(const LAS bf16x8*)(lds + PG8_SB(b, h) + boff + n * 2048 + k * 1024); } while (0)
#define PG8_MMA(ai, bj, At, Bt) do { __builtin_amdgcn_s_setprio(1); _Pragma("unroll") for (int m = 0; m < 4; ++m) _Pragma("unroll") for (int n = 0; n < 2; ++n) _Pragma("unroll") for (int k = 0; k < 2; ++k) \
        acc[ai][bj][m][n] = __builtin_amdgcn_mfma_f32_16x16x32_bf16(Bt[n][k], At[m][k], acc[ai][bj][m][n], 0, 0, 0); __builtin_amdgcn_s_setprio(0); } while (0)
#define PG8_WAIT_V(n) asm volatile("s_waitcnt vmcnt(" #n ")" ::: "memory")
#define PG8_WAIT_L(n) asm volatile("s_waitcnt lgkmcnt(" #n ")" ::: "memory")
#define PG8_BAR __builtin_amdgcn_s_barrier()
#define PG8_SCHED __builtin_amdgcn_sched_barrier(0)
    Unit cur, nxt; int ui = 0, seg = 0;
    if (!S.next(0, cur)) return;
    f32x4 acc[2][2][4][2];
#pragma unroll
    for (int a = 0; a < 2; ++a)
#pragma unroll
        for (int b = 0; b < 2; ++b)
#pragma unroll
            for (int m = 0; m < 4; ++m)
#pragma unroll
                for (int n = 0; n < 2; ++n) acc[a][b][m][n] = (f32x4){0.f, 0.f, 0.f, 0.f};
    bf16x8 At[4][2], B0[2][2], B1[2][2];
    const char* cA = (const char*)g.A(0) + (size_t)cur.pm * (2 * hstepAx); const char* cB = (const char*)g.B(0) + (size_t)cur.pn * tstepB;
    int nt = g.nt(0);
    unsigned voffA[2] = {voffAx[0], voffAx[1]}; size_t hstepA = hstepAx;
    PG8_STAGE(PG8_SB(0, 0), cB, voffB); PG8_STAGE(PG8_SB(0, 1), cB + hstepB, voffB); PG8_STAGE(PG8_SA(0, 0), cA, voffA); PG8_STAGE(PG8_SA(0, 1), cA + hstepA, voffA);
    if (wr == 1) PG8_BAR;
    PG8_WAIT_V(2); PG8_BAR;
    PG8_STAGE(PG8_SB(1, 0), cB + kstep, voffB); PG8_STAGE(PG8_SA(1, 0), cA + kstep, voffA); PG8_STAGE(PG8_SB(1, 1), cB + hstepB + kstep, voffB);
    PG8_WAIT_V(6); PG8_BAR;
    for (;;) {
        const int nseg = (seg == 2) ? 0 : seg + 1;
        bool has_next = true; if (seg == 2) has_next = S.next(ui + 1, nxt); else nxt = cur;
        const size_t nhstepA = has_next ? (nseg ? hstepAq : hstepAx) : hstepA;
        unsigned nvoffA[2]; nvoffA[0] = has_next ? (nseg ? voffAq[0] : voffAx[0]) : voffA[0]; nvoffA[1] = has_next ? (nseg ? voffAq[1] : voffAx[1]) : voffA[1];
        const char* nA = has_next ? (const char*)g.A(nseg) + (size_t)nxt.pm * (2 * nhstepA) : cA; const char* nB = has_next ? (const char*)g.B(nseg) + (size_t)nxt.pn * tstepB : cB;
        for (int t = 0; t < nt; t += 2) {
            const bool last = (t == nt - 2);
            const char* a1 = cA + (size_t)(t + 1) * kstep;
            const char* a2 = last ? nA : cA + (size_t)(t + 2) * kstep; const char* b2 = last ? nB : cB + (size_t)(t + 2) * kstep;
            const char* a3 = a2 + kstep; const char* b3 = b2 + kstep;
            unsigned vA2[2]; vA2[0] = last ? nvoffA[0] : voffA[0]; vA2[1] = last ? nvoffA[1] : voffA[1]; const size_t hA2 = last ? nhstepA : hstepA;
            PG8_LDB(B0, 0, 0); PG8_LDB(B1, 0, 1); PG8_SCHED; PG8_LDA(At, 0, 0); PG8_STAGE(PG8_SA(1, 1), a1 + hstepA, voffA);
            PG8_WAIT_V(8); PG8_WAIT_L(0); PG8_BAR; PG8_MMA(0, 0, At, B0); PG8_MMA(0, 1, At, B1); PG8_BAR; PG8_SCHED;
            PG8_LDA(At, 0, 1); PG8_STAGE(PG8_SB(0, 0), b2, voffB); PG8_STAGE(PG8_SB(0, 1), b2 + hstepB, voffB); PG8_STAGE(PG8_SA(0, 0), a2, vA2);
            PG8_WAIT_V(8); PG8_WAIT_L(0); PG8_BAR; PG8_MMA(1, 0, At, B0); PG8_MMA(1, 1, At, B1); PG8_BAR; PG8_SCHED;
            PG8_LDB(B0, 1, 0); PG8_LDB(B1, 1, 1); PG8_SCHED; PG8_LDA(At, 1, 0); PG8_STAGE(PG8_SA(0, 1), a2 + hA2, vA2);
            PG8_WAIT_V(8); PG8_WAIT_L(0); PG8_BAR; PG8_MMA(0, 0, At, B0); PG8_MMA(0, 1, At, B1); PG8_BAR; PG8_SCHED;
            PG8_LDA(At, 1, 1); PG8_STAGE(PG8_SB(1, 0), b3, voffB); PG8_STAGE(PG8_SB(1, 1), b3 + hstepB, voffB); PG8_STAGE(PG8_SA(1, 0), a3, vA2);
            PG8_WAIT_V(8); PG8_WAIT_L(0); PG8_BAR; PG8_MMA(1, 0, At, B0); PG8_MMA(1, 1, At, B1); PG8_BAR; PG8_SCHED;
        }
        if (wr == 0) PG8_BAR;
        E(acc, cur, seg, wr, wc, fr, fq);
        if (!has_next) break;
        if (seg == 2) {
#pragma unroll
        for (int a = 0; a < 2; ++a)
#pragma unroll
            for (int b = 0; b < 2; ++b)
#pragma unroll
                for (int m = 0; m < 4; ++m)
#pragma unroll
                    for (int n = 0; n < 2; ++n) acc[a][b][m][n] = (f32x4){0.f, 0.f, 0.f, 0.f};
        ++ui; }
        cur = nxt; cA = nA; cB = nB; seg = nseg; nt = g.nt(seg); voffA[0] = nvoffA[0]; voffA[1] = nvoffA[1]; hstepA = nhstepA;
        if (wr == 1) PG8_BAR;
    }
    PG8_WAIT_V(0);
    PG8_BAR;
#undef PG8_SA
#undef PG8_SB
#undef PG8_STAGE
#undef PG8_LDA
#undef PG8_LDB
#undef PG8_MMA
#undef PG8_WAIT_V
#undef PG8_WAIT_L
#undef PG8_BAR
#undef PG8_SCHED
}

#define EPI_LOOP_BEGIN \
    const int row0 = u.pm * BM + wr * 64 + fr; const int colt = u.pn * BM + wc * 32 + 8 * fq; \
    _Pragma("unroll") for (int ai = 0; ai < 2; ++ai) _Pragma("unroll") for (int m = 0; m < 4; ++m) { const int row = row0 + ai * HALF + m * 16; \
        _Pragma("unroll") for (int bj = 0; bj < 2; ++bj) { const int col = colt + bj * HALF; f32x4 v0 = acc[ai][bj][m][0], v1 = acc[ai][bj][m][1];
#define EPI_LOOP_END } if (m == 3) asm volatile("" ::: "memory"); }

__device__ __forceinline__ u32x4 pack8(f32x4 v0, f32x4 v1) { u32x4 w; w.x = cvt_pk_bf16(v0[0], v0[1]); w.y = cvt_pk_bf16(v0[2], v0[3]); w.z = cvt_pk_bf16(v1[0], v1[1]); w.w = cvt_pk_bf16(v1[2], v1[3]); return w; }

struct EpiProj {
    bf16_t* O;
    __device__ __forceinline__ void operator()(f32x4 (&acc)[2][2][4][2], const Unit& u, int wr, int wc, int fr, int fq) const {
        const int pn = u.pn; const int mode = (pn >= 4 && pn < 8) ? 1 : ((pn == 8 || pn == 9 || pn == 14 || pn == 15) ? 2 : 0);
        const float qs = 0.125f * LOG2E;
        const int q_ = pn - 8; const int pitch = (pn < 8) ? XP : QP;
        bf16_t* dst = (pn < 8) ? O + (size_t)(pn >> 2) * (MT * XP) + (pn & 3) * 256 : O + O_DQ + (size_t)(q_ >> 1) * (MT * QP) + (q_ & 1) * 256;
        EPI_LOOP_BEGIN
            if (mode == 1) {
#pragma unroll
                for (int e = 0; e < 4; ++e) { v0[e] = gelu_tanh(v0[e]); v1[e] = gelu_tanh(v1[e]); }
            } else if (mode == 2) { v0 = v0 * qs; v1 = v1 * qs; }
            *(u32x4*)(dst + (size_t)row * pitch + (col - u.pn * BM)) = pack8(v0, v1);
        EPI_LOOP_END
    }
};
__device__ __forceinline__ size_t gate_frag_off(int pm, int pnl, int wave, int ai, int m, int bj, int lane, size_t gbase) {
    const int blk = (((pm * 4 + pnl) * 8 + wave) * 16) + ((ai * 4 + m) * 2 + bj);
    return gbase + (size_t)blk * 512 + lane * 8;
}
struct EpiGates {
    bf16_t* O; const float* gb;
    __device__ __forceinline__ void operator()(f32x4 (&acc)[2][2][4][2], const Unit& u, int wr, int wc, int fr, int fq) const {
        const int b = u.pn >> 2; const size_t cbase = (size_t)b * (b == 1 ? O_DK : O_FK / 2);     const int wave = wr * 4 + wc, lane = fq * 16 + fr;
        EPI_LOOP_BEGIN
            (void)row;
            const f32x4 b0 = *(const f32x4*)(gb + col), b1 = *(const f32x4*)(gb + col + 4);
#pragma unroll
            for (int e = 0; e < 4; ++e) { v0[e] = sigmoidf_(v0[e] + b0[e]); v1[e] = sigmoidf_(v1[e] + b1[e]); }
            *(u32x4*)(O + gate_frag_off(u.pm, u.pn & 3, wave, ai, m, bj, lane, cbase)) = pack8(v0, v1);
        EPI_LOOP_END
    }
};
struct EpiResid {
    const float* in; float* out; int rowoff;
    __device__ __forceinline__ void operator()(f32x4 (&acc)[2][2][4][2], const Unit& u, int wr, int wc, int fr, int fq) const {
        EPI_LOOP_BEGIN
            const size_t off = (size_t)(row + rowoff) * DM + col;
            const f32x4 a0 = *(const f32x4*)(in + off), a1 = *(const f32x4*)(in + off + 4);
            *(f32x4*)(out + off) = a0 + v0; *(f32x4*)(out + off + 4) = a1 + v1;
        EPI_LOOP_END
    }
};
struct EpiStore {
    bf16_t* O; int ldc;
    __device__ __forceinline__ void operator()(f32x4 (&acc)[2][2][4][2], const Unit& u, int wr, int wc, int fr, int fq) const {
        EPI_LOOP_BEGIN
            *(u32x4*)(O + (size_t)row * ldc + col) = pack8(v0, v1);
        EPI_LOOP_END
    }
};

__device__ __forceinline__ float dpp_ror1(float x) { return __builtin_bit_cast(float, __builtin_amdgcn_mov_dpp(__builtin_bit_cast(int, x), 0x121, 0xf, 0xf, true)); }
__device__ __forceinline__ float dpp_ror2(float x) { return __builtin_bit_cast(float, __builtin_amdgcn_mov_dpp(__builtin_bit_cast(int, x), 0x122, 0xf, 0xf, true)); }

struct EpiResidNorm {
    const float* in; float* out; bf16_t* xg; const float* g; float* sumsq;
    __device__ __forceinline__ void operator()(f32x4 (&acc)[2][2][4][2], const Unit& u, int wr, int wc, int fr, int fq) const {
        const int row0 = u.pm * BM + wr * 64 + fr; const int colt = u.pn * BM + wc * 32 + 8 * fq;
#pragma unroll
        for (int ai = 0; ai < 2; ++ai)
#pragma unroll
            for (int m = 0; m < 4; ++m) { const int row = row0 + ai * HALF + m * 16; float ss = 0.f;
#pragma unroll
                for (int bj = 0; bj < 2; ++bj) { const int col = colt + bj * HALF; const size_t off = (size_t)row * DM + col;
                    const f32x4 x0 = *(const f32x4*)(in + off) + acc[ai][bj][m][0], x1 = *(const f32x4*)(in + off + 4) + acc[ai][bj][m][1];
                    *(f32x4*)(out + off) = x0; *(f32x4*)(out + off + 4) = x1;
                    const f32x4 g0 = *(const f32x4*)(g + col), g1 = *(const f32x4*)(g + col + 4);
                    *(u32x4*)(xg + off) = pack8(x0 * g0, x1 * g1);
                    ss += (x0[0] * x0[0] + x0[1] * x0[1]) + (x0[2] * x0[2] + x0[3] * x0[3]) + (x1[0] * x1[0] + x1[1] * x1[1]) + (x1[2] * x1[2] + x1[3] * x1[3]); }
                ss += __shfl_xor(ss, 16); ss += __shfl_xor(ss, 32);
                if (fq == 0) atomicAdd(sumsq + row, ss);
                if (m == 3) asm volatile("" ::: "memory"); }
    }
};

struct EpiFfn {
    bf16_t* act; float* halo; const float* cw; const float* cb; const float* sumsq;
    __device__ __forceinline__ void operator()(f32x4 (&acc)[2][2][4][2], const Unit& u, int wr, int wc, int fr, int fq) const {
        float rs[2][4];
#pragma unroll
        for (int ai = 0; ai < 2; ++ai)
#pragma unroll
            for (int m = 0; m < 4; ++m) rs[ai][m] = fast_rsq(sumsq[u.pm * BM + ai * HALF + wr * 64 + m * 16 + fr] * (1.0f / DM) + EPS);
#pragma unroll
        for (int n = 0; n < 2; ++n) {
            const int ch0 = u.pn * 128 + wc * 32 + 8 * fq + 4 * n;
            const f32x4 wg0 = *(const f32x4*)(cw + ch0), wg1 = *(const f32x4*)(cw + DFF2 + ch0), wg2 = *(const f32x4*)(cw + 2 * DFF2 + ch0), bg = *(const f32x4*)(cb + ch0);
            const f32x4 wv0 = *(const f32x4*)(cw + DFF + ch0), wv1 = *(const f32x4*)(cw + DFF2 + DFF + ch0), wv2 = *(const f32x4*)(cw + 2 * DFF2 + DFF + ch0), bv = *(const f32x4*)(cb + DFF + ch0);
#pragma unroll
            for (int ai = 0; ai < 2; ++ai) {
                const int blk = u.pm * 4 + ai * 2 + wr;
                f32x4 pg = {0.f, 0.f, 0.f, 0.f}, pv = {0.f, 0.f, 0.f, 0.f};
#pragma unroll
                for (int m = 0; m < 4; ++m) {
                    const int row = u.pm * BM + ai * HALF + wr * 64 + m * 16 + fr;
                    const f32x4 gq = acc[ai][0][m][n] * rs[ai][m], vq = acc[ai][1][m][n] * rs[ai][m];
                    f32x4 g1, g2, v1, v2;
#pragma unroll
                    for (int e = 0; e < 4; ++e) {
                        g1[e] = dpp_ror1(fr == 15 ? pg[e] : gq[e]); g2[e] = dpp_ror2(fr >= 14 ? pg[e] : gq[e]); v1[e] = dpp_ror1(fr == 15 ? pv[e] : vq[e]); v2[e] = dpp_ror2(fr >= 14 ? pv[e] : vq[e]); }
                    const f32x4 cg = bg + wg0 * g2 + wg1 * g1 + wg2 * gq, cv = bv + wv0 * v2 + wv1 * v1 + wv2 * vq;
                    {
                        u32x2 w; w.x = cvt_pk_bf16(gelu_tanh(cg[0]) * cv[0], gelu_tanh(cg[1]) * cv[1]); w.y = cvt_pk_bf16(gelu_tanh(cg[2]) * cv[2], gelu_tanh(cg[3]) * cv[3]);
                        *(u32x2*)(act + (size_t)row * DFF + ch0) = w; }
                    if (m == 0 && fr < 2) { float* hp = halo + ((size_t)blk * 4 + fr) * DFF2 + ch0; *(f32x4*)hp = gq; *(f32x4*)(hp + DFF) = vq; }
                    if (m == 3 && fr >= 14) { float* hp = halo + ((size_t)blk * 4 + fr - 12) * DFF2 + ch0; *(f32x4*)hp = gq; *(f32x4*)(hp + DFF) = vq; }
                    pg = gq; pv = vq;
                }
                asm volatile("" ::: "memory");
            }
        }
    }
};
struct EpiMerge3 {
    const bf16_t* P; bf16_t* Mb;
    __device__ __forceinline__ void operator()(f32x4 (&acc)[2][2][4][2], const Unit& u, int seg, int wr, int wc, int fr, int fq) const {
        const size_t ga = (size_t)seg * (seg == 1 ? O_DK : O_FK / 2), gb = (seg == 0 ? O_DK : O_FK); const int wave = wr * 4 + wc, lane = fq * 16 + fr;
        const int row0 = u.pm * BM + wr * 64 + fr; const int colt = u.pn * BM + wc * 32 + 8 * fq;
#pragma unroll
        for (int ai = 0; ai < 2; ++ai)
#pragma unroll
            for (int m = 0; m < 4; ++m) { const int row = row0 + ai * HALF + m * 16;
#pragma unroll
                for (int bj = 0; bj < 2; ++bj) { const int col = colt + bj * HALF;
                    const u32x4 aw = *(const u32x4*)(P + gate_frag_off(u.pm, u.pn, wave, ai, m, bj, lane, ga));
                    f32x4 s0 = {bflo(aw.x), bfhi(aw.x), bflo(aw.y), bfhi(aw.y)}, s1 = {bflo(aw.z), bfhi(aw.z), bflo(aw.w), bfhi(aw.w)};
                    if (seg != 2) { const u32x4 bw = *(const u32x4*)(P + gate_frag_off(u.pm, u.pn, wave, ai, m, bj, lane, gb));
                        const f32x4 d0 = {bflo(bw.x), bfhi(bw.x), bflo(bw.y), bfhi(bw.y)}, d1 = {bflo(bw.z), bfhi(bw.z), bflo(bw.w), bfhi(bw.w)};
#pragma unroll
                        for (int e = 0; e < 4; ++e) { s0[e] *= fast_rcp(d0[e]); s1[e] *= fast_rcp(d1[e]); } }
                    acc[ai][bj][m][0] *= s0; acc[ai][bj][m][1] *= s1;
                    if (seg == 2) *(u32x4*)(Mb + (size_t)row * DM + col) = pack8(acc[ai][bj][m][0], acc[ai][bj][m][1]); }
                if (m == 3) asm volatile("" ::: "memory"); }
    }
};
}

struct Params { const float* in[28]; float* out; unsigned char* ws; };
enum { I_X = 0, I_N1G, I_WIN, I_RCW, I_RCB, I_RGWR, I_RGBR, I_RGWI, I_RGBI, I_RGA, I_LQ1, I_LK1, I_LQ2, I_LK2, I_SUBG, I_REL, I_FOXB, I_GATEB,
       I_WBR_RNN, I_WBR_DIFF, I_WBR_FOX, I_WOUT, I_N2G, I_FUP, I_FCW, I_FCB, I_FDOWN, I_FINALG };

__constant__ unsigned char T5_BUCKET[128] = {0, 1, 2, 3, 4, 5, 6, 7, 8, 9, 10, 11, 12, 13, 14, 15, 16, 16, 16, 17, 17, 18, 18, 18, 19, 19, 19, 20, 20, 20, 20, 21, 21, 21, 21, 22, 22, 22, 22, 22, 23, 23, 23, 23, 23, 23, 24, 24, 24, 24, 24, 24, 25, 25, 25, 25, 25, 25, 25, 26, 26, 26, 26, 26, 26, 26, 26, 27, 27, 27, 27, 27, 27, 27, 27, 27, 27, 28, 28, 28, 28, 28, 28, 28, 28, 28, 28, 29, 29, 29, 29, 29, 29, 29, 29, 29, 29, 29, 29, 30, 30, 30, 30, 30, 30, 30, 30, 30, 30, 30, 30, 30, 30, 31, 31, 31, 31, 31, 31, 31, 31, 31, 31, 31, 31, 31, 31, 31};

template <bool FFN_PERM = false>
__device__ __forceinline__ void transpose_item(const float* W, int ldw, int K, bf16_t* WT, int nblk, int item, LAS float* scr, int lane) {
    const int kb = item / nblk, nb = item % nblk, k0 = 64 * kb, n0 = 32 * nb;
    const int d0 = FFN_PERM ? ((n0 < DFF) ? ((n0 >> 7) * 256 + (n0 & 127)) : ((((n0 - DFF) >> 7) * 256) + 128 + ((n0 - DFF) & 127))) : n0;
#pragma unroll 8
    for (int i = 0; i < 32; ++i) { const int kk = 2 * i + (lane >> 5); scr[kk * 33 + (lane & 31)] = W[(size_t)(k0 + kk) * ldw + n0 + (lane & 31)]; }
    asm volatile("s_waitcnt lgkmcnt(0)" ::: "memory");
    const int c = lane & 7;
#pragma unroll
    for (int j = 0; j < 4; ++j) { const int n = (lane >> 3) + 8 * j; const LAS float* s = scr + (8 * c) * 33 + n;
        u32x4 o; o.x = pk2(s[0 * 33], s[1 * 33]); o.y = pk2(s[2 * 33], s[3 * 33]); o.z = pk2(s[4 * 33], s[5 * 33]); o.w = pk2(s[6 * 33], s[7 * 33]);
        *(u32x4*)(WT + (size_t)(d0 + n) * K + k0 + 8 * c) = o; }
    asm volatile("s_waitcnt lgkmcnt(0)" ::: "memory");
}

__device__ __forceinline__ void convert_weights(const Params& P, int l, LAS unsigned char* lds, int gw, int NGW, int wid, int lane) {
    LAS float* scr = (LAS float*)(lds + wid * 8704);
    unsigned char* ws = launder_ptr(P.ws);
    constexpr int I0 = 16 * 160, I1 = 16 * 96, I2 = 16 * 32, I3 = 8 * 32, I4 = 8 * 32, I5 = 16 * 32, I6 = 16 * 176, I7 = 44 * 32, I8 = 64, I9 = 64;
    constexpr int NITEMS = I0 + I1 + I2 + I3 + I4 + I5 + I6 + I7 + I8 + I9;
    for (int it = gw; it < NITEMS; it += NGW) {
        int r = it;
        if (r < I0) { transpose_item(P.in[I_WIN] + (size_t)l * DM * NIN, NIN, DM, (bf16_t*)(ws + WS_WIN), 160, r, scr, lane); continue; } r -= I0;
        if (r < I1) { transpose_item(P.in[I_WIN] + (size_t)l * DM * NIN + 5128, NIN, DM, (bf16_t*)(ws + WS_WIN) + (size_t)5120 * DM, 96, r, scr, lane); continue; } r -= I1;
        if (r < I2) { transpose_item(P.in[I_WBR_RNN] + (size_t)l * DM * DM, DM, DM, (bf16_t*)(ws + WS_WBR_RNN), 32, r, scr, lane); continue; } r -= I2;
        if (r < I3) { transpose_item(P.in[I_WBR_DIFF] + (size_t)l * 512 * DM, DM, DM, (bf16_t*)(ws + WS_WBR_DIFF), 32, r, scr, lane); continue; } r -= I3;
        if (r < I4) { transpose_item(P.in[I_WBR_FOX] + (size_t)l * 512 * DM, DM, DM, (bf16_t*)(ws + WS_WBR_FOX), 32, r, scr, lane); continue; } r -= I4;
        if (r < I5) { transpose_item(P.in[I_WOUT] + (size_t)l * DM * DM, DM, DM, (bf16_t*)(ws + WS_WOUT), 32, r, scr, lane); continue; } r -= I5;
        if (r < I6) { transpose_item<true>(P.in[I_FUP] + (size_t)l * DM * DFF2, DFF2, DM, (bf16_t*)(ws + WS_WUP), 176, r, scr, lane); continue; } r -= I6;
        if (r < I7) { transpose_item(P.in[I_FDOWN] + (size_t)l * DFF * DM, DM, DFF, (bf16_t*)(ws + WS_WDOWN), 32, r, scr, lane); continue; } r -= I7;
        if (r < I8) { const int n = r >> 3; transpose_item(P.in[I_RGWR] + (size_t)l * 131072 + n * 16384, 128, 128, (bf16_t*)(ws + WS_RGR) + n * 16384, 4, r & 7, scr, lane); continue; } r -= I8;
        { const int n = r >> 3; transpose_item(P.in[I_RGWI] + (size_t)l * 131072 + n * 16384, 128, 128, (bf16_t*)(ws + WS_RGI) + n * 16384, 4, r & 7, scr, lane); }
    }
}

template <bool WITH_F>
__device__ __forceinline__ void rmsnorm_rows(const float* x, const float* g, bf16_t* hout, const Params& P, int l, LAS unsigned char* lds, int gw, int NGW, int lane) {
    LAS f32x4* wf = (LAS f32x4*)(lds + 73728);
    if (WITH_F) {
        const float* win = P.in[I_WIN] + (size_t)l * DM * NIN;
        for (int idx = threadIdx.x; idx < 8192; idx += blockDim.x) { const int k = idx >> 3, jj = idx & 7;
            const float v = g[k] * win[(size_t)k * NIN + 5120 + jj];
            const int ln = (k & 255) >> 2, e = k & 3, j = k >> 8, half = jj >> 2;
            ((LAS float*)wf)[((((j * 4 + e) * 2 + half) * 64 + ln) << 2) + (jj & 3)] = v; }
        __syncthreads();
    }
    f32x4 gv[4];
#pragma unroll
    for (int j = 0; j < 4; ++j) gv[j] = ((const f32x4*)g)[lane + 64 * j];
    const float bfv = WITH_F ? P.in[I_FOXB][l * 8 + (lane & 7)] : 0.f;
    for (int m = gw; m < MTOK; m += NGW) {
        const f32x4* xr = (const f32x4*)(x + (size_t)m * DM) + lane;
        f32x4 v[4]; float ss = 0.f;
#pragma unroll
        for (int j = 0; j < 4; ++j) { v[j] = xr[64 * j]; ss += (v[j].x * v[j].x + v[j].y * v[j].y) + (v[j].z * v[j].z + v[j].w * v[j].w); }
        const float rstd = fast_rsq(wave_sum(ss) * (1.0f / DM) + EPS);
        unsigned long long* o8 = (unsigned long long*)(hout + (size_t)m * DM) + lane;
#pragma unroll
        for (int j = 0; j < 4; ++j) { const f32x4 hv = v[j] * rstd * gv[j];
            o8[64 * j] = (unsigned long long)pk2(hv.x, hv.y) | ((unsigned long long)pk2(hv.z, hv.w) << 32); }
        if (WITH_F) {
            float a[8];
#pragma unroll
            for (int q = 0; q < 8; ++q) a[q] = 0.f;
#pragma unroll
            for (int j = 0; j < 4; ++j)
#pragma unroll
                for (int e = 0; e < 4; ++e) { const f32x4 w0 = wf[((j * 4 + e) * 2 + 0) * 64 + lane], w1 = wf[((j * 4 + e) * 2 + 1) * 64 + lane]; const float xv = v[j][e];
                    a[0] += xv * w0.x; a[1] += xv * w0.y; a[2] += xv * w0.z; a[3] += xv * w0.w; a[4] += xv * w1.x; a[5] += xv * w1.y; a[6] += xv * w1.z; a[7] += xv * w1.w; }
            float mine = 0.f;
#pragma unroll
            for (int q = 0; q < 8; ++q) { const float s = wave_sum(a[q]); if ((lane & 7) == q) mine = s; }
            if (lane < 8) { const float z = mine * rstd + bfv; const float lf = -(fmaxf(-z, 0.f) + log1p_small(fast_exp2(-fabsf(z) * LOG2E)));
                ((float*)(launder_ptr(P.ws) + WS_LOGF))[(size_t)m * 8 + lane] = lf; }
        }
    }
}

__device__ __forceinline__ void cumsum_logf(const Params& P, int b, int wid, int lane) {
    unsigned char* ws_ = launder_ptr(P.ws);
    const float* lf = (const float*)(ws_ + WS_LOGF) + (size_t)b * SEQ * 8 + wid;
    float* c = (float*)(ws_ + WS_C) + (size_t)b * SEQ * 8 + wid;
    float v[32]; float s = 0.f;
#pragma unroll
    for (int i = 0; i < 32; ++i) { s += lf[(size_t)(lane * 32 + i) * 8]; v[i] = s; }
    float inc = s;
#pragma unroll
    for (int o = 1; o < 64; o <<= 1) { const float t = __shfl_up(inc, o); if (lane >= o) inc += t; }
    const float excl = inc - s;
#pragma unroll
    for (int i = 0; i < 32; ++i) c[(size_t)(lane * 32 + i) * 8] = (excl + v[i]) * LOG2E;
}

__device__ __forceinline__ void rglru_unit(const Params& P, int l, int unit, LAS unsigned char* lds, bool dry = false) {
    const int tid = launder_tid(), lane = tid & 63, wid = __builtin_amdgcn_readfirstlane(tid >> 6), r32 = lane & 31, hi = lane >> 5;
    const int j = unit & 1, n = (unit >> 1) & 7, b = unit >> 4;
    unsigned char* ws_ = launder_ptr(P.ws);
    const int tb = wid & 3, cb = wid >> 2;
    const int dch = 64 * j + 32 * cb + r32, dglob = 128 * n + dch;
    bf16_t* proj = (bf16_t*)(ws_ + WS_P);
    LAS unsigned char* WB = lds + 104448;
    {
#pragma unroll
      for (int i = 0; i < 4; ++i) { const int idx = tid + 512 * i, gate = idx >> 10, rem = idx & 1023, d = rem >> 4, ch = rem & 15;
          const bf16_t* srcw = (const bf16_t*)(ws_ + (gate ? WS_RGI : WS_RGR)) + n * 16384 + (64 * j + d) * 128 + ch * 8;
          *(LAS u32x4*)(WB + (gate * 64 + d) * 272 + ch * 16) = *(const u32x4*)srcw; } }
    const float br = P.in[I_RGBR][l * DM + dglob], bi = P.in[I_RGBI][l * DM + dglob];
    const float ap_ = P.in[I_RGA][l * DM + dglob]; const float sp8 = 8.0f * (fmaxf(-ap_, 0.f) + log1p_small(fast_exp2(-fabsf(ap_) * LOG2E)));
    const int cc = tid & 15, rg = tid >> 4;
    float cw[4][8], cbias[8];
#pragma unroll
    for (int e = 0; e < 8; ++e) { cbias[e] = P.in[I_RCB][l * DM + 128 * n + 8 * cc + e];
#pragma unroll
        for (int k = 0; k < 4; ++k) cw[k][e] = P.in[I_RCW][(l * 4 + k) * DM + 128 * n + 8 * cc + e]; }
    LAS unsigned char* xc = lds;
    LAS float* Ab = (LAS float*)(lds + 34816);
    LAS float* Ub = (LAS float*)(lds + 67584);
    LAS f32x2* seg = (LAS f32x2*)(lds + 100352);
    float carry = 0.f;
    const size_t rowb = (size_t)b * SEQ;
    u32x4 xw[7];
#define RG_XLOAD(T0) do { _Pragma("unroll") for (int k = 0; k < 7; ++k) { const int t = (T0) + 4 * rg - 3 + k; xw[k] = (u32x4){0u, 0u, 0u, 0u}; \
        if (t >= 0) xw[k] = *(const u32x4*)(proj + O_XR + (rowb + t) * XP + 128 * n + 8 * cc); } } while (0)
    RG_XLOAD(0);
    for (int tile = 0; tile < SEQ / 128; ++tile) {
        const int t0 = tile * 128;
        {
            float xv[7][8];
#pragma unroll
            for (int k = 0; k < 7; ++k) { const u32x4 w = xw[k];
                xv[k][0] = bflo(w.x); xv[k][1] = bfhi(w.x); xv[k][2] = bflo(w.y); xv[k][3] = bfhi(w.y); xv[k][4] = bflo(w.z); xv[k][5] = bfhi(w.z); xv[k][6] = bflo(w.w); xv[k][7] = bfhi(w.w); }
#pragma unroll
            for (int i = 0; i < 4; ++i) { float o[8];
#pragma unroll
                for (int e = 0; e < 8; ++e) o[e] = cbias[e] + cw[0][e] * xv[i][e] + cw[1][e] * xv[i + 1][e] + cw[2][e] * xv[i + 2][e] + cw[3][e] * xv[i + 3][e];
                u32x4 w; w.x = pk2(o[0], o[1]); w.y = pk2(o[2], o[3]); w.z = pk2(o[4], o[5]); w.w = pk2(o[6], o[7]);
                *(LAS u32x4*)(xc + (4 * rg + i) * 272 + cc * 16) = w; }
        }
        if (tile + 1 < SEQ / 128) RG_XLOAD(t0 + 128);
        const int sc = lane, ss = wid;
        bf16_t* gp = proj + O_GR + (rowb + t0 + 16 * ss) * XP + 128 * n + 64 * j + sc;
        unsigned short gq[16];
#pragma unroll
        for (int k = 0; k < 16; ++k) gq[k] = gp[(size_t)k * XP];
        __syncthreads();
        f32x16 accr = {}, acci = {};
#pragma unroll
        for (int s = 0; s < 8; ++s) { const bf16x8 a = *(const LAS bf16x8*)(xc + (32 * tb + r32) * 272 + (16 * s + 8 * hi) * 2);
            const bf16x8 wr_ = *(const LAS bf16x8*)(WB + (32 * cb + r32) * 272 + (16 * s + 8 * hi) * 2), wi_ = *(const LAS bf16x8*)(WB + (64 + 32 * cb + r32) * 272 + (16 * s + 8 * hi) * 2);
            accr = __builtin_amdgcn_mfma_f32_32x32x16_bf16(a, wr_, accr, 0, 0, 0); acci = __builtin_amdgcn_mfma_f32_32x32x16_bf16(a, wi_, acci, 0, 0, 0); }
#pragma unroll
        for (int r = 0; r < 16; ++r) { const int tok = 32 * tb + crow(r, hi);
            const float rr = sigmoidf_(accr[r] + br), ii = sigmoidf_(acci[r] + bi);
            const float la = -rr * sp8; const float a = fast_exp2(la * LOG2E);
            const float x2 = 2.0f * la;
            const float em = -x2 * (1.0f + x2 * (0.5f + x2 * (0.16666667f + x2 * (0.041666668f + x2 * (0.0083333338f + x2 * 0.0013888889f)))));
            const float mult = __builtin_sqrtf(fmaxf(em, 0.f));
            const float xcv = bf2f(*(const LAS unsigned short*)(xc + tok * 272 + dch * 2));
            Ab[tok * 64 + 32 * cb + r32] = a; Ub[tok * 64 + 32 * cb + r32] = mult * ii * xcv; }
        __syncthreads();
        { const int c = sc, s = ss;
          float As = 1.f, Hs = 0.f;
#pragma unroll
          for (int k = 0; k < 16; ++k) { const float a = Ab[(16 * s + k) * 64 + c], u = Ub[(16 * s + k) * 64 + c]; Hs = a * Hs + u; As *= a; }
          seg[s * 64 + c] = (f32x2){As, Hs};
          __syncthreads();
          float hin = carry, hn = carry;
#pragma unroll
          for (int s2 = 0; s2 < 8; ++s2) { if (s2 == s) hin = hn; const f32x2 sg = seg[s2 * 64 + c]; hn = sg.x * hn + sg.y; }
          carry = hn;
          float h = hin;
#pragma unroll
          for (int k = 0; k < 16; ++k) { const float a = Ab[(16 * s + k) * 64 + c], u = Ub[(16 * s + k) * 64 + c]; h = a * h + u;
              const float gg = bf2f(gq[k]); gp[(size_t)k * XP] = (bf16_t)f2bf(dry ? gg : gg * h); }
        }
    }
#undef RG_XLOAD
    __syncthreads();
}

__device__ __forceinline__ float half_max(float v) { auto rr = __builtin_amdgcn_permlane32_swap(__float_as_uint(v), __float_as_uint(v), false, false); return fmaxf(__uint_as_float(rr[0]), __uint_as_float(rr[1])); }
__device__ __forceinline__ float half_sum(float v) { auto rr = __builtin_amdgcn_permlane32_swap(__float_as_uint(v), __float_as_uint(v), false, false); return __uint_as_float(rr[0]) + __uint_as_float(rr[1]); }

__device__ __forceinline__ void attn_qk(f32x16& p0, f32x16& p1, const LAS unsigned char* Kt, int kstride, const bf16x8 (&qf)[4], int r32, int hi) {
#pragma unroll
    for (int d0 = 0; d0 < 4; ++d0) {
        const bf16x8 k0 = *(const LAS bf16x8*)(Kt + r32 * kstride + d0 * 32 + hi * 16);
        const bf16x8 k1 = *(const LAS bf16x8*)(Kt + (r32 + 32) * kstride + d0 * 32 + hi * 16);
        p0 = __builtin_amdgcn_mfma_f32_32x32x16_bf16(k0, qf[d0], p0, 0, 0, 0);
        p1 = __builtin_amdgcn_mfma_f32_32x32x16_bf16(k1, qf[d0], p1, 0, 0, 0);
    }
}

template <int NDT, int VSTR>
__device__ __forceinline__ void attn_sm_pv(f32x16& p0, f32x16& p1, f32x16& n0, f32x16& n1, bool has_next, const LAS unsigned char* Vt,
                                           f32x16 (&o)[NDT], float& mref, float& lrun, bool first, bool domask, int qrel, LAS float* wsf, int r32, int hi) {
    if (domask) {
#pragma unroll
        for (int r = 0; r < 16; ++r) { const int kv = crow(r, hi); if (kv > qrel) p0[r] = -INFINITY; if (kv + 32 > qrel) p1[r] = -INFINITY; }
    }
    float ra = fmaxf(fmaxf(p0[0], p0[1]), p1[0]), rb = fmaxf(fmaxf(p0[2], p0[3]), p1[1]);
    ra = fmaxf(fmaxf(ra, p1[2]), p1[3]);
#pragma unroll
    for (int r = 4; r < 16; r += 4) { ra = fmaxf(fmaxf(ra, p0[r]), p0[r + 1]); rb = fmaxf(fmaxf(rb, p0[r + 2]), p0[r + 3]); ra = fmaxf(fmaxf(ra, p1[r]), p1[r + 1]); rb = fmaxf(fmaxf(rb, p1[r + 2]), p1[r + 3]); }
    const float rm = half_max(fmaxf(ra, rb));
    if (first || __any(rm > 8.0f)) {
        const float dl = first ? rm : fmaxf(rm, 0.f);
        mref += dl;
#pragma unroll
        for (int r = 0; r < 16; ++r) { p0[r] -= dl; p1[r] -= dl; }
        if (has_next) {
#pragma unroll
            for (int r = 0; r < 16; ++r) { n0[r] -= dl; n1[r] -= dl; } }
        if (!first) {
            const float alpha = fast_exp2(-dl);
            lrun *= alpha;
            if (hi == 0) wsf[r32] = alpha;
            asm volatile("s_waitcnt lgkmcnt(0)" ::: "memory");
#pragma unroll
            for (int jj = 0; jj < 4; ++jj) { const f32x4 al = *(const LAS f32x4*)(wsf + 8 * jj + 4 * hi);
#pragma unroll
                for (int d = 0; d < NDT; ++d) { o[d][4 * jj + 0] *= al.x; o[d][4 * jj + 1] *= al.y; o[d][4 * jj + 2] *= al.z; o[d][4 * jj + 3] *= al.w; } }
            asm volatile("s_waitcnt lgkmcnt(0)" ::: "memory");
        }
    }
    constexpr int PRE = (NDT == 2) ? 4 : 1;
    const int lane_ = hi * 32 + r32;
    const LAS unsigned char* vb = Vt + (4 * hi + ((lane_ & 15) >> 2)) * VSTR + (16 * ((lane_ >> 4) & 1) + 4 * (lane_ & 3)) * 2;
#define VFRAG(s, d) ({ const s16x4 lo_ = __builtin_bit_cast(s16x4, __builtin_amdgcn_ds_read_tr16_b64_v4i16((LAS s16x4*)(vb + (16 * (s)) * VSTR + 64 * (d)))); \
                       const s16x4 hh_ = __builtin_bit_cast(s16x4, __builtin_amdgcn_ds_read_tr16_b64_v4i16((LAS s16x4*)(vb + (16 * (s) + 8) * VSTR + 64 * (d)))); \
                       (bf16x8){lo_[0], lo_[1], lo_[2], lo_[3], hh_[0], hh_[1], hh_[2], hh_[3]}; })
    bf16x8 vpre[PRE][NDT];
#pragma unroll
    for (int s = 0; s < PRE; ++s)
#pragma unroll
        for (int d = 0; d < NDT; ++d) vpre[s][d] = VFRAG(s, d);
    float rs0 = 0.f, rs1 = 0.f;
#pragma unroll
    for (int r = 0; r < 16; ++r) { p0[r] = fast_exp2(p0[r]); p1[r] = fast_exp2(p1[r]); rs0 += p0[r]; rs1 += p1[r]; }
    lrun += rs0 + rs1;
    bf16x8 pa[4];
#pragma unroll
    for (int s = 0; s < 2; ++s) {
        u32x4 w0, w1;
        w0.x = cvt_pk_bf16(p0[8 * s + 0], p0[8 * s + 1]); w0.y = cvt_pk_bf16(p0[8 * s + 2], p0[8 * s + 3]); w0.z = cvt_pk_bf16(p0[8 * s + 4], p0[8 * s + 5]); w0.w = cvt_pk_bf16(p0[8 * s + 6], p0[8 * s + 7]);
        w1.x = cvt_pk_bf16(p1[8 * s + 0], p1[8 * s + 1]); w1.y = cvt_pk_bf16(p1[8 * s + 2], p1[8 * s + 3]); w1.z = cvt_pk_bf16(p1[8 * s + 4], p1[8 * s + 5]); w1.w = cvt_pk_bf16(p1[8 * s + 6], p1[8 * s + 7]);
        pa[s] = __builtin_bit_cast(bf16x8, w0); pa[2 + s] = __builtin_bit_cast(bf16x8, w1);
    }
#pragma unroll
    for (int s = 0; s < 4; ++s) {
        bf16x8 vw[NDT];
#pragma unroll
        for (int d = 0; d < NDT; ++d) { if (s < PRE) vw[d] = vpre[s < PRE ? s : 0][d]; else vw[d] = VFRAG(s, d); }
#pragma unroll
        for (int d = 0; d < NDT; ++d) o[d] = __builtin_amdgcn_mfma_f32_32x32x16_bf16(pa[s], vw[d], o[d], 0, 0, 0);
    }
#undef VFRAG
}

#define SBAR_() __builtin_amdgcn_sched_barrier(0)
__device__ __forceinline__ float rowmax32(const f32x16& a, const f32x16& b) {
    float ra = fmaxf(fmaxf(a[0], a[1]), b[0]), rb = fmaxf(fmaxf(a[2], a[3]), b[1]);
    ra = fmaxf(fmaxf(ra, b[2]), b[3]);
#pragma unroll
    for (int r = 4; r < 16; r += 4) { ra = fmaxf(fmaxf(ra, a[r]), a[r + 1]); rb = fmaxf(fmaxf(rb, a[r + 2]), a[r + 3]); ra = fmaxf(fmaxf(ra, b[r]), b[r + 1]); rb = fmaxf(fmaxf(rb, b[r + 2]), b[r + 3]); }
    return half_max(fmaxf(ra, rb));
}
__device__ __forceinline__ void fox_steady_step(f32x16& s0, f32x16& s1, f32x16& n0, f32x16& n1, const LAS unsigned char* kb, int coff, const LAS unsigned char* Vt,
                                                const bf16x8 (&qf)[4], f32x16 (&o)[2], float& mref, float& lrun, float cq, LAS float* wsf, int r32, int hi, float& rmc) {
    const float rm = rmc;
    if (__any(rm > 8.0f)) {
        const float dl = fmaxf(rm, 0.f);
        mref += dl;
#pragma unroll
        for (int r = 0; r < 16; ++r) { s0[r] -= dl; s1[r] -= dl; }
        const float alpha = fast_exp2(-dl);
        lrun *= alpha;
        if (hi == 0) wsf[r32] = alpha;
        asm volatile("s_waitcnt lgkmcnt(0)" ::: "memory");
#pragma unroll
        for (int jj = 0; jj < 4; ++jj) { const f32x4 al = *(const LAS f32x4*)(wsf + 8 * jj + 4 * hi);
#pragma unroll
            for (int d = 0; d < 2; ++d) { o[d][4 * jj + 0] *= al.x; o[d][4 * jj + 1] *= al.y; o[d][4 * jj + 2] *= al.z; o[d][4 * jj + 3] *= al.w; } }
        asm volatile("s_waitcnt lgkmcnt(0)" ::: "memory");
    }
    bf16x8 kf[8]; f32x4 ck4[8]; bf16x8 vf[4][2];
#pragma unroll
    for (int d0 = 0; d0 < 4; ++d0) { kf[2 * d0] = *(const LAS bf16x8*)(kb + r32 * 144 + d0 * 32 + hi * 16); kf[2 * d0 + 1] = *(const LAS bf16x8*)(kb + (r32 + 32) * 144 + d0 * 32 + hi * 16); }
#pragma unroll
    for (int jj = 0; jj < 4; ++jj) { ck4[jj] = *(const LAS f32x4*)(kb + coff + (8 * jj + 4 * hi) * 4); ck4[4 + jj] = *(const LAS f32x4*)(kb + coff + (32 + 8 * jj + 4 * hi) * 4); }
    { const int lane_ = hi * 32 + r32;
      const LAS unsigned char* vb = Vt + (4 * hi + ((lane_ & 15) >> 2)) * 192 + (16 * ((lane_ >> 4) & 1) + 4 * (lane_ & 3)) * 2;
#pragma unroll
      for (int s = 0; s < 4; ++s)
#pragma unroll
          for (int d = 0; d < 2; ++d) {
              const s16x4 lo_ = __builtin_bit_cast(s16x4, __builtin_amdgcn_ds_read_tr16_b64_v4i16((LAS s16x4*)(vb + (16 * s) * 192 + 64 * d)));
              const s16x4 hh_ = __builtin_bit_cast(s16x4, __builtin_amdgcn_ds_read_tr16_b64_v4i16((LAS s16x4*)(vb + (16 * s + 8) * 192 + 64 * d)));
              vf[s][d] = (bf16x8){lo_[0], lo_[1], lo_[2], lo_[3], hh_[0], hh_[1], hh_[2], hh_[3]}; } }
    { const float cqm = cq - mref;
#pragma unroll
      for (int jj = 0; jj < 4; ++jj)
#pragma unroll
          for (int e = 0; e < 4; ++e) { n0[4 * jj + e] = cqm - ck4[jj][e]; n1[4 * jj + e] = cqm - ck4[4 + jj][e]; } }
    SBAR_();
    float rs = 0.f; u32x4 w0, w1, w2, w3;
#define EXPN_(P, B, N) do { _Pragma("unroll") for (int e_ = 0; e_ < (N); ++e_) { P[(B) + e_] = fast_exp2(P[(B) + e_]); rs += P[(B) + e_]; } } while (0)
    n0 = __builtin_amdgcn_mfma_f32_32x32x16_bf16(kf[0], qf[0], n0, 0, 0, 0); EXPN_(s0, 0, 3); SBAR_();
    n1 = __builtin_amdgcn_mfma_f32_32x32x16_bf16(kf[1], qf[0], n1, 0, 0, 0); EXPN_(s0, 3, 3); w0.x = cvt_pk_bf16(s0[0], s0[1]); w0.y = cvt_pk_bf16(s0[2], s0[3]); SBAR_();
    n0 = __builtin_amdgcn_mfma_f32_32x32x16_bf16(kf[2], qf[1], n0, 0, 0, 0); EXPN_(s0, 6, 3); w0.z = cvt_pk_bf16(s0[4], s0[5]); w0.w = cvt_pk_bf16(s0[6], s0[7]); SBAR_();
    n1 = __builtin_amdgcn_mfma_f32_32x32x16_bf16(kf[3], qf[1], n1, 0, 0, 0); EXPN_(s0, 9, 3); w1.x = cvt_pk_bf16(s0[8], s0[9]); w1.y = cvt_pk_bf16(s0[10], s0[11]); SBAR_();
    n0 = __builtin_amdgcn_mfma_f32_32x32x16_bf16(kf[4], qf[2], n0, 0, 0, 0); EXPN_(s0, 12, 4); w1.z = cvt_pk_bf16(s0[12], s0[13]); w1.w = cvt_pk_bf16(s0[14], s0[15]); SBAR_();
    n1 = __builtin_amdgcn_mfma_f32_32x32x16_bf16(kf[5], qf[2], n1, 0, 0, 0); EXPN_(s1, 0, 3); SBAR_();
    n0 = __builtin_amdgcn_mfma_f32_32x32x16_bf16(kf[6], qf[3], n0, 0, 0, 0); EXPN_(s1, 3, 3); w2.x = cvt_pk_bf16(s1[0], s1[1]); w2.y = cvt_pk_bf16(s1[2], s1[3]); SBAR_();
    n1 = __builtin_amdgcn_mfma_f32_32x32x16_bf16(kf[7], qf[3], n1, 0, 0, 0); EXPN_(s1, 6, 2); w2.z = cvt_pk_bf16(s1[4], s1[5]); w2.w = cvt_pk_bf16(s1[6], s1[7]); SBAR_();
    const bf16x8 pa0 = __builtin_bit_cast(bf16x8, w0), pa1 = __builtin_bit_cast(bf16x8, w1), pa2 = __builtin_bit_cast(bf16x8, w2);
    float ra = fmaxf(fmaxf(n0[0], n0[1]), n1[0]), rb = fmaxf(fmaxf(n0[2], n0[3]), n1[1]);
    o[0] = __builtin_amdgcn_mfma_f32_32x32x16_bf16(pa0, vf[0][0], o[0], 0, 0, 0); EXPN_(s1, 8, 2); ra = fmaxf(fmaxf(ra, n1[2]), n1[3]); SBAR_();
    o[1] = __builtin_amdgcn_mfma_f32_32x32x16_bf16(pa0, vf[0][1], o[1], 0, 0, 0); EXPN_(s1, 10, 2); w3.x = cvt_pk_bf16(s1[8], s1[9]); rb = fmaxf(fmaxf(rb, n0[4]), n0[5]); SBAR_();
    o[0] = __builtin_amdgcn_mfma_f32_32x32x16_bf16(pa1, vf[1][0], o[0], 0, 0, 0); EXPN_(s1, 12, 2); w3.y = cvt_pk_bf16(s1[10], s1[11]); ra = fmaxf(fmaxf(ra, n0[6]), n0[7]); SBAR_();
    o[1] = __builtin_amdgcn_mfma_f32_32x32x16_bf16(pa1, vf[1][1], o[1], 0, 0, 0); EXPN_(s1, 14, 2); w3.z = cvt_pk_bf16(s1[12], s1[13]); rb = fmaxf(fmaxf(rb, n1[4]), n1[5]); SBAR_();
    o[0] = __builtin_amdgcn_mfma_f32_32x32x16_bf16(pa2, vf[2][0], o[0], 0, 0, 0); w3.w = cvt_pk_bf16(s1[14], s1[15]); ra = fmaxf(fmaxf(ra, n1[6]), n1[7]); rb = fmaxf(fmaxf(rb, n0[8]), n0[9]); SBAR_();
    o[1] = __builtin_amdgcn_mfma_f32_32x32x16_bf16(pa2, vf[2][1], o[1], 0, 0, 0); ra = fmaxf(fmaxf(ra, n0[10]), n0[11]); rb = fmaxf(fmaxf(rb, n1[8]), n1[9]); ra = fmaxf(fmaxf(ra, n1[10]), n1[11]); rb = fmaxf(fmaxf(rb, n0[12]), n0[13]); SBAR_();
    const bf16x8 pa3 = __builtin_bit_cast(bf16x8, w3);
    lrun += rs;
    o[0] = __builtin_amdgcn_mfma_f32_32x32x16_bf16(pa3, vf[3][0], o[0], 0, 0, 0); ra = fmaxf(fmaxf(ra, n0[14]), n0[15]); rb = fmaxf(fmaxf(rb, n1[12]), n1[13]); ra = fmaxf(fmaxf(ra, n1[14]), n1[15]); SBAR_();
    o[1] = __builtin_amdgcn_mfma_f32_32x32x16_bf16(pa3, vf[3][1], o[1], 0, 0, 0);
#undef EXPN_
    rmc = half_max(fmaxf(ra, rb));
}

__device__ __forceinline__ void fox_unit(const Params& P, int b, int h, int qb, LAS unsigned char* lds, bool dry = false) {
    unsigned char* ws_ = launder_ptr(P.ws);
    const int tid = launder_tid(), lane = tid & 63, wid = __builtin_amdgcn_readfirstlane(tid >> 6), r32 = lane & 31, hi = lane >> 5;
    bf16_t* proj = (bf16_t*)(ws_ + WS_P);
    const float* cbuf = (const float*)(ws_ + WS_C);
    const size_t rowb = (size_t)b * SEQ; const int q0 = qb * 256;
    constexpr int BUFB = 21760, KOFF = 0, VOFF = 9216, COFF = 21504, FVS = 192;
    LAS float* wsf = (LAS float*)(lds + 2 * BUFB) + wid * 64;
    bf16x8 qf[4];
    { const bf16_t* Qw = proj + O_FQ + (rowb + q0 + wid * 32 + r32) * QP + h * 64;
#pragma unroll
      for (int d0 = 0; d0 < 4; ++d0) qf[d0] = *(const bf16x8*)(Qw + d0 * 16 + hi * 8); }
    const float cq = cbuf[(rowb + q0 + wid * 32 + r32) * 8 + h];
    f32x16 o[2]; o[0] = f32x16{}; o[1] = f32x16{};
    float mref = 0.f, lrun = 0.f;
    const int NT = 4 * (qb + 1);
    const int srow = tid >> 3, sch = tid & 7;
    u32x4 kreg, vreg; float creg = 0.f;
    const bf16_t* sbase = proj + (rowb + srow) * QP + h * 64 + sch * 8;
#define FOX_GLOADK(t) do { kreg = *(const u32x4*)(sbase + O_FK + (size_t)(64 * (t)) * QP); if (tid < 64) creg = cbuf[(rowb + 64 * (t) + tid) * 8 + h]; } while (0)
#define FOX_GLOADV(t) do { vreg = *(const u32x4*)(sbase + O_FV + (size_t)(64 * (t)) * QP); } while (0)
#define FOX_LSTOREK(buf) do { LAS unsigned char* bb_ = lds + (buf) * BUFB; *(LAS u32x4*)(bb_ + KOFF + srow * 144 + sch * 16) = kreg; if (tid < 64) *(LAS float*)(bb_ + COFF + tid * 4) = creg; } while (0)
#define FOX_LSTOREV(buf) (*(LAS u32x4*)(lds + (buf) * BUFB + VOFF + srow * FVS + sch * 16) = vreg)
#define FOX_INIT(P0, P1, buf) do { const LAS unsigned char* bb_ = lds + (buf) * BUFB; const float cqm = cq - mref; \
        _Pragma("unroll") for (int jj = 0; jj < 4; ++jj) { const f32x4 c0 = *(const LAS f32x4*)(bb_ + COFF + (8 * jj + 4 * hi) * 4), c1 = *(const LAS f32x4*)(bb_ + COFF + (32 + 8 * jj + 4 * hi) * 4); \
            _Pragma("unroll") for (int e = 0; e < 4; ++e) { P0[4 * jj + e] = cqm - c0[e]; P1[4 * jj + e] = cqm - c1[e]; } } } while (0)
    FOX_GLOADK(0); FOX_GLOADV(0); FOX_LSTOREK(0); FOX_LSTOREV(0);
    FOX_GLOADK(1); FOX_LSTOREK(1);
    __syncthreads();
    f32x16 s0, s1, n0 = {}, n1 = {};
    FOX_INIT(s0, s1, 0); attn_qk(s0, s1, lds + KOFF, 144, qf, r32, hi);
#define FOX_ITER(t, S0, S1, N0, N1) do { \
        if ((t) + 2 < NT) FOX_GLOADK((t) + 2); \
        if ((t) + 1 < NT) FOX_GLOADV((t) + 1); \
        const int jb = (t) - (NT - 4); \
        const bool active = (jb < 0) || (jb <= (wid >> 1)); \
        const bool act_next = ((t) + 1 < NT) && ((jb + 1 < 0) || (jb + 1 <= (wid >> 1))); \
        if (act_next) { FOX_INIT(N0, N1, ((t) + 1) & 1); attn_qk(N0, N1, lds + (((t) + 1) & 1) * BUFB + KOFF, 144, qf, r32, hi); } \
        if (active) { const bool domask = (jb >= 0) && (64 * jb + 63 > 32 * wid); \
            attn_sm_pv<2, 192>(S0, S1, N0, N1, act_next, lds + ((t) & 1) * BUFB + VOFF, o, mref, lrun, (t) == 0, domask, q0 + wid * 32 + r32 - 64 * (t), wsf, r32, hi); } \
        if ((t) + 2 < NT) FOX_LSTOREK((t) & 1); \
        if ((t) + 1 < NT) FOX_LSTOREV(((t) + 1) & 1); \
        __syncthreads(); } while (0)
#define FOX_STEADY(t, S0, S1, N0, N1) do { \
        FOX_GLOADK((t) + 2); FOX_GLOADV((t) + 1); \
        fox_steady_step(S0, S1, N0, N1, lds + (((t) + 1) & 1) * BUFB + KOFF, COFF - KOFF, lds + ((t) & 1) * BUFB + VOFF, qf, o, mref, lrun, cq, wsf, r32, hi, rmc); \
        FOX_LSTOREK((t) & 1); FOX_LSTOREV(((t) + 1) & 1); \
        __syncthreads(); } while (0)
    FOX_ITER(0, s0, s1, n0, n1);
    int t = 1;
    float rmc = 0.f;
    if (t + 1 <= NT - 6) rmc = rowmax32(n0, n1);
    for (; t + 1 <= NT - 6; t += 2) { FOX_STEADY(t, n0, n1, s0, s1); FOX_STEADY(t + 1, s0, s1, n0, n1); }
    for (; t + 1 < NT; t += 2) { FOX_ITER(t, n0, n1, s0, s1); FOX_ITER(t + 1, s0, s1, n0, n1); }
    FOX_ITER(NT - 1, n0, n1, s0, s1);
#undef FOX_STEADY
#undef FOX_ITER
#undef FOX_GLOADK
#undef FOX_GLOADV
#undef FOX_LSTOREK
#undef FOX_LSTOREV
#undef FOX_INIT
    const float lt = half_sum(lrun);
    if (hi == 0) wsf[r32] = fast_rcp(lt);
    asm volatile("s_waitcnt lgkmcnt(0)" ::: "memory");
    bf16_t* Ow = proj + O_FQ + (rowb + q0 + wid * 32) * QP + h * 64;
#pragma unroll
    for (int r = 0; r < 16; ++r) { const int q = crow(r, hi); const float il = wsf[q];
#pragma unroll
        for (int d = 0; d < 2; ++d) if (!dry || o[d][r] == 1.2345e30f) Ow[(size_t)q * QP + 32 * d + r32] = (bf16_t)f2bf(o[d][r] * il); }
    __syncthreads();
}

__device__ __forceinline__ void diff_steady_step(f32x16& s0, f32x16& s1, f32x16& n0, f32x16& n1, const LAS unsigned char* kb, const LAS unsigned char* Vt, const LAS unsigned char* qlds,
                                                 f32x16 (&o)[4], float& mref, float& lrun, float b31, LAS float* wsf, int r32, int hi, float& rmc, const bf16_t* vsrc, size_t vstep, u32x4 (&vreg)[2]) {
    const float rm = rmc;
    if (__any(rm > 8.0f)) {
        const float dl = fmaxf(rm, 0.f);
        mref += dl;
#pragma unroll
        for (int r = 0; r < 16; ++r) { s0[r] -= dl; s1[r] -= dl; }
        const float alpha = fast_exp2(-dl);
        lrun *= alpha;
        if (hi == 0) wsf[r32] = alpha;
        asm volatile("s_waitcnt lgkmcnt(0)" ::: "memory");
#pragma unroll
        for (int jj = 0; jj < 4; ++jj) { const f32x4 al = *(const LAS f32x4*)(wsf + 8 * jj + 4 * hi);
#pragma unroll
            for (int d = 0; d < 4; ++d) { o[d][4 * jj + 0] *= al.x; o[d][4 * jj + 1] *= al.y; o[d][4 * jj + 2] *= al.z; o[d][4 * jj + 3] *= al.w; } }
        asm volatile("s_waitcnt lgkmcnt(0)" ::: "memory");
    }
    const int lane_ = hi * 32 + r32;
    const LAS unsigned char* vb = Vt + (4 * hi + ((lane_ & 15) >> 2)) * 320 + (16 * ((lane_ >> 4) & 1) + 4 * (lane_ & 3)) * 2;
#define DVF_(s, d) ({ const s16x4 lo_ = __builtin_bit_cast(s16x4, __builtin_amdgcn_ds_read_tr16_b64_v4i16((LAS s16x4*)(vb + (16 * (s)) * 320 + 64 * (d)))); \
                      const s16x4 hh_ = __builtin_bit_cast(s16x4, __builtin_amdgcn_ds_read_tr16_b64_v4i16((LAS s16x4*)(vb + (16 * (s) + 8) * 320 + 64 * (d)))); \
                      (bf16x8){lo_[0], lo_[1], lo_[2], lo_[3], hh_[0], hh_[1], hh_[2], hh_[3]}; })
    bf16x8 ka[3], kc[3], va[4];
#define DKF_(dst, d0) do { dst[0] = *(const LAS bf16x8*)(kb + r32 * 272 + (d0) * 32 + hi * 16); dst[1] = *(const LAS bf16x8*)(kb + (r32 + 32) * 272 + (d0) * 32 + hi * 16); dst[2] = *(const LAS bf16x8*)(qlds + (d0) * 32); } while (0)
    DKF_(ka, 0); DKF_(kc, 1);
    { const float v_ = b31 - mref;
#pragma unroll
      for (int r = 0; r < 16; ++r) { n0[r] = v_; n1[r] = v_; } }
    SBAR_();
    float rs = 0.f; u32x4 w0, w1, w2, w3;
#define EXPN_(P, B, N) do { _Pragma("unroll") for (int e_ = 0; e_ < (N); ++e_) { P[(B) + e_] = fast_exp2(P[(B) + e_]); rs += P[(B) + e_]; } } while (0)
#define MF_(dst, a_, b_) dst = __builtin_amdgcn_mfma_f32_32x32x16_bf16(a_, b_, dst, 0, 0, 0)
    MF_(n0, ka[0], ka[2]); EXPN_(s0, 0, 2); SBAR_();
    MF_(n1, ka[1], ka[2]); DKF_(ka, 2); EXPN_(s0, 2, 2); w0.x = cvt_pk_bf16(s0[0], s0[1]); SBAR_();
    MF_(n0, kc[0], kc[2]); EXPN_(s0, 4, 2); w0.y = cvt_pk_bf16(s0[2], s0[3]); SBAR_();
    MF_(n1, kc[1], kc[2]); DKF_(kc, 3); EXPN_(s0, 6, 2); w0.z = cvt_pk_bf16(s0[4], s0[5]); SBAR_();
    MF_(n0, ka[0], ka[2]); EXPN_(s0, 8, 2); w0.w = cvt_pk_bf16(s0[6], s0[7]); SBAR_();
    MF_(n1, ka[1], ka[2]); EXPN_(s0, 10, 2); w1.x = cvt_pk_bf16(s0[8], s0[9]); SBAR_();
    MF_(n0, kc[0], kc[2]); EXPN_(s0, 12, 2); w1.y = cvt_pk_bf16(s0[10], s0[11]); SBAR_();
#pragma unroll
    for (int d = 0; d < 4; ++d) va[d] = DVF_(0, d);
    MF_(n1, kc[1], kc[2]); EXPN_(s0, 14, 2); w1.z = cvt_pk_bf16(s0[12], s0[13]); w1.w = cvt_pk_bf16(s0[14], s0[15]); SBAR_();
    vreg[0] = *(const u32x4*)vsrc; vreg[1] = *(const u32x4*)(vsrc + vstep);
    const bf16x8 pa0 = __builtin_bit_cast(bf16x8, w0), pa1 = __builtin_bit_cast(bf16x8, w1);
    SBAR_();
    MF_(o[0], pa0, va[0]); EXPN_(s1, 0, 2); SBAR_();
    MF_(o[1], pa0, va[1]); EXPN_(s1, 2, 2); w2.x = cvt_pk_bf16(s1[0], s1[1]); SBAR_();
    MF_(o[2], pa0, va[2]); EXPN_(s1, 4, 2); w2.y = cvt_pk_bf16(s1[2], s1[3]); SBAR_();
    MF_(o[3], pa0, va[3]); EXPN_(s1, 6, 2); w2.z = cvt_pk_bf16(s1[4], s1[5]); w2.w = cvt_pk_bf16(s1[6], s1[7]); SBAR_();
#pragma unroll
    for (int d = 0; d < 4; ++d) va[d] = DVF_(1, d);
    SBAR_();
    MF_(o[0], pa1, va[0]); EXPN_(s1, 8, 2); SBAR_();
    MF_(o[1], pa1, va[1]); EXPN_(s1, 10, 2); w3.x = cvt_pk_bf16(s1[8], s1[9]); SBAR_();
    MF_(o[2], pa1, va[2]); EXPN_(s1, 12, 2); w3.y = cvt_pk_bf16(s1[10], s1[11]); SBAR_();
    MF_(o[3], pa1, va[3]); EXPN_(s1, 14, 2); w3.z = cvt_pk_bf16(s1[12], s1[13]); w3.w = cvt_pk_bf16(s1[14], s1[15]); SBAR_();
    lrun += rs;
    const bf16x8 pa2 = __builtin_bit_cast(bf16x8, w2), pa3 = __builtin_bit_cast(bf16x8, w3);
#pragma unroll
    for (int d = 0; d < 4; ++d) va[d] = DVF_(2, d);
    SBAR_();
    float ra = fmaxf(fmaxf(n0[0], n0[1]), n1[0]), rb = fmaxf(fmaxf(n0[2], n0[3]), n1[1]);
    MF_(o[0], pa2, va[0]); ra = fmaxf(fmaxf(ra, n1[2]), n1[3]); rb = fmaxf(fmaxf(rb, n0[4]), n0[5]); SBAR_();
    MF_(o[1], pa2, va[1]); ra = fmaxf(fmaxf(ra, n0[6]), n0[7]); rb = fmaxf(fmaxf(rb, n1[4]), n1[5]); SBAR_();
    MF_(o[2], pa2, va[2]); ra = fmaxf(fmaxf(ra, n1[6]), n1[7]); rb = fmaxf(fmaxf(rb, n0[8]), n0[9]); SBAR_();
    MF_(o[3], pa2, va[3]); ra = fmaxf(fmaxf(ra, n0[10]), n0[11]); rb = fmaxf(fmaxf(rb, n1[8]), n1[9]); SBAR_();
#pragma unroll
    for (int d = 0; d < 4; ++d) va[d] = DVF_(3, d);
    SBAR_();
    MF_(o[0], pa3, va[0]); ra = fmaxf(fmaxf(ra, n1[10]), n1[11]); rb = fmaxf(fmaxf(rb, n0[12]), n0[13]); SBAR_();
    MF_(o[1], pa3, va[1]); ra = fmaxf(fmaxf(ra, n0[14]), n0[15]); rb = fmaxf(fmaxf(rb, n1[12]), n1[13]); SBAR_();
    MF_(o[2], pa3, va[2]); ra = fmaxf(fmaxf(ra, n1[14]), n1[15]); SBAR_();
    MF_(o[3], pa3, va[3]);
#undef EXPN_
#undef MF_
#undef DVF_
#undef DKF_
    rmc = half_max(fmaxf(ra, rb));
}

__device__ __forceinline__ void diff_unit(const Params& P, int l, int b, int h, int qb, float lam, float lam_init, LAS unsigned char* lds, bool dry = false) {
    unsigned char* ws_ = launder_ptr(P.ws);
    const int tid = launder_tid(), lane = tid & 63, wid = __builtin_amdgcn_readfirstlane(tid >> 6), r32 = lane & 31, hi = lane >> 5;
    const int map = wid >> 2, wq = wid & 3;
    bf16_t* proj = (bf16_t*)(ws_ + WS_P);
    const size_t rowb = (size_t)b * SEQ; const int q0 = qb * 128;
    constexpr int BUFB = 37888, KOFF = 0, VOFF = 17408, DVS = 320;
    LAS float* wsf = (LAS float*)(lds + 2 * BUFB) + wid * 64;
    LAS float* bt = (LAS float*)(lds + 77824);
    LAS float* xch = (LAS float*)(lds + 79872);
    if (tid < 128) bt[tid] = P.in[I_REL][T5_BUCKET[tid] * 4 + h] * LOG2E;
    LAS unsigned char* qlds = lds + 79872 + wid * 4608 + r32 * 144 + hi * 16;
    { const bf16_t* Qw = proj + O_DQ + (rowb + q0 + wq * 32 + r32) * QP + h * 128 + map * 64;
#pragma unroll
      for (int d0 = 0; d0 < 4; ++d0) *(LAS bf16x8*)(qlds + d0 * 32) = *(const bf16x8*)(Qw + d0 * 16 + hi * 8); }
#define DIFF_QK(P0, P1, kt) do { bf16x8 qf[4]; _Pragma("unroll") for (int d0 = 0; d0 < 4; ++d0) qf[d0] = *(const LAS bf16x8*)(qlds + d0 * 32); attn_qk(P0, P1, kt, 272, qf, r32, hi); } while (0)
    f32x16 o[4];
#pragma unroll
    for (int d = 0; d < 4; ++d) o[d] = f32x16{};
    float mref = 0.f, lrun = 0.f;
    const int NT = 2 * (qb + 1);
    u32x4 kreg[2], vreg[2];
    const int srow = tid >> 4, sch = tid & 15;
    const bf16_t* sbase = proj + (rowb + srow) * QP + h * 128 + sch * 8;
#define DIFF_GLOADK(t) do { _Pragma("unroll") for (int i = 0; i < 2; ++i) kreg[i] = *(const u32x4*)(sbase + O_DK + (size_t)(64 * (t) + 32 * i) * QP); } while (0)
#define DIFF_GLOADV(t) do { _Pragma("unroll") for (int i = 0; i < 2; ++i) vreg[i] = *(const u32x4*)(sbase + O_DV + (size_t)(64 * (t) + 32 * i) * QP); } while (0)
#define DIFF_LSTOREK(buf) do { _Pragma("unroll") for (int i = 0; i < 2; ++i) *(LAS u32x4*)(lds + (buf) * BUFB + KOFF + (srow + 32 * i) * 272 + sch * 16) = kreg[i]; } while (0)
#define DIFF_LSTOREV(buf) do { _Pragma("unroll") for (int i = 0; i < 2; ++i) *(LAS u32x4*)(lds + (buf) * BUFB + VOFF + (srow + 32 * i) * DVS + sch * 16) = vreg[i]; } while (0)
    const int qme = q0 + wq * 32 + r32;
#define DIFF_INIT(P0, P1, t) do { const int qrel_ = qme - 64 * (t); \
        if (q0 + wq * 32 - (64 * (t) + 63) >= 113) { const float v_ = b31 - mref; _Pragma("unroll") for (int r = 0; r < 16; ++r) { P0[r] = v_; P1[r] = v_; } } \
        else { _Pragma("unroll") for (int r = 0; r < 16; ++r) { const int d0_ = qrel_ - crow(r, hi), d1_ = d0_ - 32; \
                 P0[r] = bt[min(max(d0_, 0), 127)] - mref; P1[r] = bt[min(max(d1_, 0), 127)] - mref; } } } while (0)
    DIFF_GLOADK(0); DIFF_GLOADV(0); DIFF_LSTOREK(0); DIFF_LSTOREV(0);
    DIFF_GLOADK(1); DIFF_LSTOREK(1);
    __syncthreads();
    const float b31 = bt[127];
    f32x16 s0, s1, n0 = {}, n1 = {};
    DIFF_INIT(s0, s1, 0); DIFF_QK(s0, s1, lds + KOFF + map * 128);
#define DIFF_ITER(t, S0, S1, N0, N1) do { \
        if ((t) + 2 < NT) DIFF_GLOADK((t) + 2); \
        if ((t) + 1 < NT) DIFF_GLOADV((t) + 1); \
        const int jb = (t) - (NT - 2); \
        const bool active = (jb < 0) || (jb <= (wq >> 1)); \
        const bool act_next = ((t) + 1 < NT) && ((jb + 1 < 0) || (jb + 1 <= (wq >> 1))); \
        if (act_next) { DIFF_INIT(N0, N1, (t) + 1); DIFF_QK(N0, N1, lds + (((t) + 1) & 1) * BUFB + KOFF + map * 128); } \
        if (active) { const bool domask = (jb >= 0) && (64 * jb + 63 > 32 * wq); \
            attn_sm_pv<4, 320>(S0, S1, N0, N1, act_next, lds + ((t) & 1) * BUFB + VOFF, o, mref, lrun, (t) == 0, domask, qme - 64 * (t), wsf, r32, hi); } \
        if ((t) + 2 < NT) DIFF_LSTOREK((t) & 1); \
        if ((t) + 1 < NT) DIFF_LSTOREV(((t) + 1) & 1); \
        __syncthreads(); } while (0)
#define DIFF_STEADY(t, S0, S1, N0, N1) do { \
        DIFF_GLOADK((t) + 2); \
        diff_steady_step(S0, S1, N0, N1, lds + (((t) + 1) & 1) * BUFB + KOFF + map * 128, lds + ((t) & 1) * BUFB + VOFF, qlds, o, mref, lrun, b31, wsf, r32, hi, rmc, sbase + O_DV + (size_t)(64 * ((t) + 1)) * QP, (size_t)32 * QP, vreg); \
        DIFF_LSTOREK((t) & 1); DIFF_LSTOREV(((t) + 1) & 1); \
        __syncthreads(); } while (0)
    DIFF_ITER(0, s0, s1, n0, n1);
    int t = 1;
    float rmc = 0.f;
    if (t + 1 <= NT - 6) rmc = rowmax32(n0, n1);
    for (; t + 1 <= NT - 6; t += 2) { DIFF_STEADY(t, n0, n1, s0, s1); DIFF_STEADY(t + 1, s0, s1, n0, n1); }
    for (; t + 1 < NT; t += 2) { DIFF_ITER(t, n0, n1, s0, s1); DIFF_ITER(t + 1, s0, s1, n0, n1); }
    DIFF_ITER(NT - 1, n0, n1, s0, s1);
#undef DIFF_STEADY
#undef DIFF_ITER
#undef DIFF_GLOADK
#undef DIFF_GLOADV
#undef DIFF_LSTOREK
#undef DIFF_LSTOREV
#undef DIFF_INIT
#undef DIFF_QK
    const float lt = half_sum(lrun);
    if (hi == 0) wsf[r32] = fast_rcp(lt) * (map ? lam : 1.0f);
    asm volatile("s_waitcnt lgkmcnt(0)" ::: "memory");
    float il[16];
#pragma unroll
    for (int r = 0; r < 16; ++r) il[r] = wsf[crow(r, hi)];
    if (map == 1) {
#pragma unroll
        for (int d = 0; d < 4; ++d)
#pragma unroll
            for (int r = 0; r < 16; ++r) xch[((wq * 4 + d) * 16 + r) * 64 + lane] = o[d][r] * il[r];
    }
    __syncthreads();
    if (map == 0) {
        float ssq[16];
#pragma unroll
        for (int r = 0; r < 16; ++r) ssq[r] = 0.f;
#pragma unroll
        for (int d = 0; d < 4; ++d)
#pragma unroll
            for (int r = 0; r < 16; ++r) { const float v = o[d][r] * il[r] - xch[((wq * 4 + d) * 16 + r) * 64 + lane]; o[d][r] = v; ssq[r] += v * v; }
#pragma unroll
        for (int r = 0; r < 16; ++r) {
#pragma unroll
            for (int s = 1; s < 32; s <<= 1) ssq[r] += __shfl_xor(ssq[r], s);
        }
        const float post = 1.0f - lam_init;
        float gsub[4];
#pragma unroll
        for (int d = 0; d < 4; ++d) gsub[d] = P.in[I_SUBG][l * 128 + 32 * d + r32] * post;
        bf16_t* Ow = proj + O_DQ + (rowb + q0 + wq * 32) * QP + h * 128;
#pragma unroll
        for (int r = 0; r < 16; ++r) { const int q = crow(r, hi); const float rstd = fast_rsq(ssq[r] * (1.0f / 128.0f) + EPS);
#pragma unroll
            for (int d = 0; d < 4; ++d) if (!dry || o[d][r] == 1.2345e30f) Ow[(size_t)q * QP + 32 * d + r32] = (bf16_t)f2bf(o[d][r] * rstd * gsub[d]); }
    }
    __syncthreads();
}

__device__ __forceinline__ void ffn_fixup(const Params& P, int l, int pm, int tid) {
    unsigned char* ws_ = launder_ptr(P.ws);
    const float* halo = (const float*)(ws_ + WS_HALO); bf16_t* act = (bf16_t*)(ws_ + WS_ACT);
    const float* cw = P.in[I_FCW] + (size_t)l * 3 * DFF2; const float* cb = P.in[I_FCB] + (size_t)l * DFF2;
    for (int it = tid; it < 4 * (DFF / 4); it += 512) {
        const int bi = it / (DFF / 4), ch0 = 4 * (it % (DFF / 4)); const int blk = pm * 4 + bi;
        const f32x4 z = {0.f, 0.f, 0.f, 0.f};
        f32x4 gm2 = z, gm1 = z, vm2 = z, vm1 = z;
        if ((blk & 31) != 0) { const float* hp = halo + ((size_t)(blk - 1) * 4 + 2) * DFF2 + ch0;
            gm2 = *(const f32x4*)hp; vm2 = *(const f32x4*)(hp + DFF); gm1 = *(const f32x4*)(hp + DFF2); vm1 = *(const f32x4*)(hp + DFF2 + DFF); }
        const float* hc = halo + ((size_t)blk * 4) * DFF2 + ch0;
        const f32x4 g0 = *(const f32x4*)hc, v0 = *(const f32x4*)(hc + DFF), g1 = *(const f32x4*)(hc + DFF2), v1 = *(const f32x4*)(hc + DFF2 + DFF);
        const f32x4 wg0 = *(const f32x4*)(cw + ch0), wg1 = *(const f32x4*)(cw + DFF2 + ch0), wg2 = *(const f32x4*)(cw + 2 * DFF2 + ch0), bg = *(const f32x4*)(cb + ch0);
        const f32x4 wv0 = *(const f32x4*)(cw + DFF + ch0), wv1 = *(const f32x4*)(cw + DFF2 + DFF + ch0), wv2 = *(const f32x4*)(cw + 2 * DFF2 + DFF + ch0), bv = *(const f32x4*)(cb + DFF + ch0);
        { const f32x4 cg = bg + wg0 * gm2 + wg1 * gm1 + wg2 * g0, cv = bv + wv0 * vm2 + wv1 * vm1 + wv2 * v0;
          u32x2 w; w.x = pk2(gelu_tanh(cg[0]) * cv[0], gelu_tanh(cg[1]) * cv[1]); w.y = pk2(gelu_tanh(cg[2]) * cv[2], gelu_tanh(cg[3]) * cv[3]);
          *(u32x2*)(act + (size_t)(blk * 64) * DFF + ch0) = w; }
        { const f32x4 cg = bg + wg0 * gm1 + wg1 * g0 + wg2 * g1, cv = bv + wv0 * vm1 + wv1 * v0 + wv2 * v1;
          u32x2 w; w.x = pk2(gelu_tanh(cg[0]) * cv[0], gelu_tanh(cg[1]) * cv[1]); w.y = pk2(gelu_tanh(cg[2]) * cv[2], gelu_tanh(cg[3]) * cv[3]);
          *(u32x2*)(act + (size_t)(blk * 64 + 1) * DFF + ch0) = w; }
    }
}

__device__ __forceinline__ void final_norm(float* x, const float* g, int gw, int NGW, int lane) {
    f32x4 gv[4];
#pragma unroll
    for (int j = 0; j < 4; ++j) gv[j] = ((const f32x4*)g)[lane + 64 * j];
    for (int m = gw; m < MTOK; m += NGW) {
        f32x4* xr = (f32x4*)(x + (size_t)m * DM) + lane;
        f32x4 v[4]; float ss = 0.f;
#pragma unroll
        for (int j = 0; j < 4; ++j) { v[j] = xr[64 * j]; ss += (v[j].x * v[j].x + v[j].y * v[j].y) + (v[j].z * v[j].z + v[j].w * v[j].w); }
        const float rstd = fast_rsq(wave_sum(ss) * (1.0f / DM) + EPS);
#pragma unroll
        for (int j = 0; j < 4; ++j) xr[64 * j] = v[j] * rstd * gv[j];
    }
}


#define XB_TMO      128
#define XB_XCNT(j)  (256  + 64 * (j))
#define XB_XSUB(j)  (1280 + 64 * (j))
#define XB_XGEN(j)  (2304 + 64 * (j))
#define XB_TOP      3328
#define XB_TOPGEN   3392
#define XCD_BAR_WORDS 3456
#define XB_SPIN_CAP (1u << 22)
__device__ __forceinline__ unsigned xb_ld(unsigned* p)              { return __hip_atomic_load(p, __ATOMIC_RELAXED, __HIP_MEMORY_SCOPE_AGENT); }
__device__ __forceinline__ unsigned xb_add(unsigned* p, unsigned v) { return __hip_atomic_fetch_add(p, v, __ATOMIC_RELAXED, __HIP_MEMORY_SCOPE_AGENT); }
__device__ __forceinline__ unsigned xb_xcc_id() { return (unsigned)__builtin_amdgcn_s_getreg((3 << 11) | 20) & 0xFu; }
#define XB_SPIN(cond, bar) do { unsigned _sp = 0; while (cond) { __builtin_amdgcn_s_sleep(1); \
    if ((++_sp & 255u) == 0u) { if (xb_ld(&(bar)[XB_TMO])) break; if (_sp > XB_SPIN_CAP) { atomicAdd(&(bar)[XB_TMO], 1u); break; } } } } while (0)
struct XcdBarrier { unsigned* bar; unsigned x; volatile LAS unsigned* st; };
__device__ __forceinline__ XcdBarrier xcd_barrier_post(unsigned* bar, volatile LAS unsigned* st) {
    XcdBarrier b; b.bar = bar; b.x = xb_xcc_id(); b.st = st;
    if (threadIdx.x == 0) (void)xb_add(&bar[XB_XCNT(b.x)], 1u);
    return b;
}
__device__ __forceinline__ void xcd_barrier_complete(unsigned* bar, unsigned x, unsigned& nloc, unsigned& nx) {
    const unsigned G = gridDim.x * gridDim.y * gridDim.z;
    unsigned sum, cnt, mine, sp = 0u;
    for (;;) {
        sum = 0u; cnt = 0u; mine = 0u;
#pragma unroll
        for (unsigned j = 0; j < 16; ++j) { const unsigned c = xb_ld(&bar[XB_XCNT(j)]); sum += c; cnt += (c > 0u) ? 1u : 0u; mine = (j == x) ? c : mine; }
        if (sum == G) break;
        __builtin_amdgcn_s_sleep(1);
        if ((++sp & 255u) == 0u) { if (xb_ld(&bar[XB_TMO])) break; if (sp > XB_SPIN_CAP) { atomicAdd(&bar[XB_TMO], 1u); break; } }
    }
    nloc = mine > 0u ? mine : 1u; nx = cnt > 0u ? cnt : 1u;
}
__device__ __forceinline__ void xcd_barrier(const XcdBarrier& b) {
    asm volatile("s_waitcnt vmcnt(0)" ::: "memory");
    __syncthreads();
    if (threadIdx.x == 0) {
        unsigned* bar = b.bar;
        __builtin_amdgcn_s_waitcnt(0);
        unsigned nloc = b.st[0], nx = b.st[1];
        if (nloc == 0u) { xcd_barrier_complete(bar, b.x, nloc, nx); b.st[0] = nloc; b.st[1] = nx; }
        const unsigned old = xb_add(&bar[XB_XSUB(b.x)], 1u);
        const unsigned gen = old / nloc;
        if (old + 1u == (gen + 1u) * nloc) {
            __builtin_amdgcn_fence(__ATOMIC_RELEASE, "agent");
            asm volatile("s_waitcnt vmcnt(0)" ::: "memory");
            const unsigned og = xb_add(&bar[XB_TOP], 1u);
            const unsigned tg = og / nx;
            if (og + 1u == (tg + 1u) * nx) xb_add(&bar[XB_TOPGEN], 1u);
            else XB_SPIN(xb_ld(&bar[XB_TOPGEN]) == tg, bar);
            __builtin_amdgcn_fence(__ATOMIC_ACQUIRE, "agent");
            xb_add(&bar[XB_XGEN(b.x)], 1u);
            asm volatile("s_waitcnt vmcnt(0)" ::: "memory");
        } else {
            XB_SPIN(xb_ld(&bar[XB_XGEN(b.x)]) == gen, bar);
            __builtin_amdgcn_fence(__ATOMIC_ACQUIRE, "agent");
            asm volatile("s_waitcnt vmcnt(0)" ::: "memory");
        }
    }
    __syncthreads();
}

#ifndef PHMASK
#define PHMASK 0xffffffffu
#endif
#define PH(n) ((PHMASK >> (n)) & 1u)
#ifndef PROBE_RG
#define PROBE_RG 0
#endif
#ifndef PROBE_DIFF
#define PROBE_DIFF 0
#endif
#ifndef PROBE_FOX
#define PROBE_FOX 0
#endif
#ifndef PROBE_SYNC
#define PROBE_SYNC 0
#endif
#ifndef PROBE_G1
#define PROBE_G1 0
#endif
__device__ __forceinline__ int launder_s(int v) { asm volatile("" : "+s"(v)); return v; }
#define PHASE_BEGIN { const int tid = launder_tid(); const int lane = tid & 63; const int wid = __builtin_amdgcn_readfirstlane(tid >> 6); \
    const int G = launder_s((int)gridDim.x), bx = launder_s((int)blockIdx.x); const int vcu = (G % 8 == 0) ? (bx % 8) * (G / 8) + bx / 8 : bx; \
    const int gw = vcu * 8 + wid, NGW = G * 8; unsigned char* ws = launder_ptr(P.ws); bf16_t* hbuf = (bf16_t*)(ws + WS_H); bf16_t* proj = (bf16_t*)(ws + WS_P); \
    float* xres = launder_ptr(P.out); const float* xin = (l == 0) ? launder_ptr(P.in[I_X]) : (const float*)xres; \
    (void)tid; (void)lane; (void)wid; (void)vcu; (void)gw; (void)NGW; (void)hbuf; (void)proj; (void)xin; (void)bx;
#define PHASE_END }
__global__ void __launch_bounds__(512, 2) fwd_megakernel(Params P) {
    extern __shared__ __attribute__((aligned(16))) unsigned char lds_raw[];
    LAS unsigned char* lds = (LAS unsigned char*)lds_raw;
    cg::grid_group grid = cg::this_grid();
    volatile LAS unsigned* bst = (volatile LAS unsigned*)(lds + LDS_BYTES - 64);
    if (threadIdx.x < 2) bst[threadIdx.x] = 0u;
    __syncthreads();
    (void)xcd_barrier_post((unsigned*)P.ws, bst);
#define GRID_SYNC() do { XcdBarrier xb_; xb_.bar = (unsigned*)launder_ptr(P.ws); xb_.x = xb_xcc_id(); xb_.st = (volatile LAS unsigned*)((LAS unsigned char*)lds_raw + LDS_BYTES - 64); xcd_barrier(xb_); } while (0)

    for (int l = 0; l < DEPTH; ++l) {
#if PH(1)
        PHASE_BEGIN
        convert_weights(P, l, lds, gw, NGW, wid, lane);
        __syncthreads();
        PHASE_END
#endif
#if PH(2)
        PHASE_BEGIN
        rmsnorm_rows<true>(xin, P.in[I_N1G] + l * DM, hbuf, P, l, lds, gw, NGW, lane);
        PHASE_END
#endif
        if (l == 0) grid.sync(); else GRID_SYNC();
#if PH(3)
        PHASE_BEGIN
        for (int b = bx; b < BATCH; b += G) cumsum_logf(P, b, wid, lane);
        for (int i = vcu * 512 + tid; i < MTOK; i += G * 512) ((float*)(ws + WS_SUMSQ))[i] = 0.f;
        PHASE_END
#endif
#if PH(4)
        PHASE_BEGIN
        pg8::Gemm g{hbuf, (const bf16_t*)(ws + WS_WIN), DM, DM, MTOK, 5120, DM}; pg8::StaticOrder S; S.init(MTOK, 5120, G, bx);
        pg8::EpiProj E{proj}; for (int rep = PROBE_G1; rep >= 0; --rep) pg8::gemm_phase(lds, g, S, E);
        for (int rep = 0; rep < PROBE_SYNC; ++rep) GRID_SYNC();
        PHASE_END
#endif
        GRID_SYNC();
#if PH(5)
        PHASE_BEGIN
        for (int rep = PROBE_RG; rep >= 0; --rep) for (int u = vcu; u < BATCH * 16; u += G) rglru_unit(P, l, u, lds, rep > 0);
        PHASE_END
#endif
#if PH(6)
        PHASE_BEGIN
            const float lam_init = (l == 0) ? 0.2f : 0.35550907f;
            float d1 = 0.f, d2 = 0.f;
            { const float* a1 = P.in[I_LQ1] + l * 64; const float* b1 = P.in[I_LK1] + l * 64; const float* a2 = P.in[I_LQ2] + l * 64; const float* b2 = P.in[I_LK2] + l * 64;
              d1 = wave_sum(a1[lane] * b1[lane]); d2 = wave_sum(a2[lane] * b2[lane]); }
            const float lam = fast_exp2(d1 * LOG2E) - fast_exp2(d2 * LOG2E) + lam_init;
            for (int rep = PROBE_DIFF; rep >= 0; --rep) for (int p = vcu; p < BATCH * 4 * 8; p += G) { const int bh = p >> 3, s = p & 7;
                diff_unit(P, l, bh >> 2, bh & 3, s, lam, lam_init, lds, rep > 0); diff_unit(P, l, bh >> 2, bh & 3, 15 - s, lam, lam_init, lds, rep > 0); }
        PHASE_END
#endif
#if PH(7)
        PHASE_BEGIN
        for (int rep = PROBE_FOX; rep >= 0; --rep) for (int p = vcu; p < BATCH * 8 * 4; p += G) { const int bh = p >> 2, s = p & 3;
            fox_unit(P, bh >> 3, bh & 7, s, lds, rep > 0); fox_unit(P, bh >> 3, bh & 7, 7 - s, lds, rep > 0); }
        PHASE_END
#endif
        GRID_SYNC();
#if PH(8)
        PHASE_BEGIN
        pg8::Gemm g{hbuf, (const bf16_t*)(ws + WS_WIN) + (size_t)5120 * DM, DM, DM, MTOK, 3072, DM}; pg8::StaticOrder S; S.init(MTOK, 3072, G, bx);
        pg8::EpiGates E{proj, P.in[I_GATEB] + l * 3072}; pg8::gemm_phase(lds, g, S, E);
        PHASE_END
#endif
        GRID_SYNC();
#if PH(9)
        PHASE_BEGIN
        pg8::StaticOrder S; S.init(MTOK, DM, G, bx);
        static_assert(WS_WBR_DIFF == WS_WBR_RNN + 2 * MiB && WS_WBR_FOX == WS_WBR_RNN + 4 * MiB, "Gemm3 segment arithmetic");
        pg8::Gemm3 g{proj, (const bf16_t*)(ws + WS_WBR_RNN), DM};
        pg8::EpiMerge3 E{proj, hbuf}; pg8::gemm_phase3(lds, g, S, E);
        PHASE_END
#endif
        GRID_SYNC();
#if PH(10)
        PHASE_BEGIN
        pg8::Gemm g{hbuf, (const bf16_t*)(ws + WS_WOUT), DM, DM, MTOK, DM, DM}; pg8::StaticOrder S; S.init(MTOK, DM, G, bx);
        pg8::EpiResidNorm E{xin, xres, (bf16_t*)(ws + WS_XG), P.in[I_N2G] + l * DM, (float*)(ws + WS_SUMSQ)}; pg8::gemm_phase(lds, g, S, E);
        PHASE_END
#endif
        GRID_SYNC();
#if PH(12)
        PHASE_BEGIN
        pg8::Gemm g{(const bf16_t*)(ws + WS_XG), (const bf16_t*)(ws + WS_WUP), DM, DM, MTOK, DFF2, DM}; pg8::StaticOrder S; S.init(MTOK, DFF2, G, bx);
        pg8::EpiFfn E{(bf16_t*)(ws + WS_ACT), (float*)(ws + WS_HALO), P.in[I_FCW] + (size_t)l * 3 * DFF2, P.in[I_FCB] + (size_t)l * DFF2, (const float*)(ws + WS_SUMSQ)};
        pg8::gemm_phase(lds, g, S, E);
        PHASE_END
#endif
        GRID_SYNC();
#if PH(14)
        PHASE_BEGIN
        pg8::StaticOrder S; S.init(MTOK, DM, G, bx);
        { pg8::Unit u; for (int i = 0; S.next(i, u); ++i) ffn_fixup(P, l, u.pm, tid); }
        asm volatile("s_waitcnt vmcnt(0)" ::: "memory"); __syncthreads();
        pg8::Gemm g{(const bf16_t*)(ws + WS_ACT), (const bf16_t*)(ws + WS_WDOWN), DFF, DFF, MTOK, DM, DFF};
        pg8::EpiResid E{xres, xres, 0}; pg8::gemm_phase(lds, g, S, E);
        PHASE_END
#endif
        GRID_SYNC();
    }
#if PH(15)
    { const int l = 1; PHASE_BEGIN
    final_norm(xres, P.in[I_FINALG], gw, NGW, lane);
    PHASE_END }
#endif
}

extern "C" void kernel_launch(void* const* d_in, const int* in_sizes, int n_in, void* d_out, int out_size, void* d_ws, size_t ws_size, hipStream_t stream) {
    static int grid = 0;
    if (grid == 0) {
        if (n_in != 28 || in_sizes[0] != MTOK * DM || out_size != MTOK * DM || ws_size < WS_END) {
            fprintf(stderr, "kernel_launch: unexpected shapes (n_in %d, in0 %d, out %d, ws %zu)\n", n_in, n_in > 0 ? in_sizes[0] : -1, out_size, ws_size); grid = -1; return; }
        int dev = 0, cus = 0, per_cu = 0;
        hipGetDevice(&dev); hipDeviceGetAttribute(&cus, hipDeviceAttributeMultiprocessorCount, dev);
        if (hipFuncSetAttribute((const void*)fwd_megakernel, hipFuncAttributeMaxDynamicSharedMemorySize, LDS_BYTES) != hipSuccess) { fprintf(stderr, "hipFuncSetAttribute failed\n"); grid = -1; return; }
        if (hipOccupancyMaxActiveBlocksPerMultiprocessor(&per_cu, (const void*)fwd_megakernel, 512, LDS_BYTES) != hipSuccess || per_cu < 1) per_cu = 1;
        (void)hipGetLastError();
        grid = cus * per_cu;
    }
    if (grid < 0) return;
    if (hipMemsetAsync(d_ws, 0, 16384, stream) != hipSuccess) { fprintf(stderr, "memset failed\n"); return; }
    Params p{};
    for (int i = 0; i < 28; ++i) p.in[i] = (const float*)d_in[i];
    p.out = (float*)d_out; p.ws = (unsigned char*)d_ws;
    void* args[] = {&p};
    hipError_t e = hipLaunchCooperativeKernel((const void*)fwd_megakernel, dim3(grid), dim3(512), args, LDS_BYTES, stream);
    if (e != hipSuccess) fprintf(stderr, "cooperative launch failed: %s (grid %d)\n", hipGetErrorString(e), grid);
}
```

```cpp
#include <hip/hip_runtime.h>
#include <hip/hip_cooperative_groups.h>
#include <cstdio>
#include <cstdint>
#include <cmath>
namespace cg = cooperative_groups;

#define LAS __attribute__((address_space(3)))
typedef unsigned short bf16_t;
typedef short bf16x8 __attribute__((ext_vector_type(8)));
typedef short s16x4 __attribute__((ext_vector_type(4)));
typedef float f32x4 __attribute__((ext_vector_type(4)));
typedef float f32x2 __attribute__((ext_vector_type(2)));
typedef float f32x16 __attribute__((ext_vector_type(16)));
typedef unsigned u32x4 __attribute__((ext_vector_type(4)));
typedef unsigned u32x2 __attribute__((ext_vector_type(2)));

constexpr int DM = 1024, BATCH = 16, SEQ = 2048, MTOK = BATCH * SEQ, DEPTH = 2;
constexpr int NIN = 8200, DFF = 2816, DFF2 = 5632;
constexpr int XP = 1024, QP = 512;
constexpr size_t MT = (size_t)BATCH * SEQ;
constexpr size_t O_XR = 0, O_GR = MT * XP, O_DQ = 2 * MT * XP, O_DK = O_DQ + MT * QP, O_DV = O_DK + MT * QP, O_FQ = O_DV + MT * QP, O_FK = O_FQ + MT * QP, O_FV = O_FK + MT * QP;
constexpr float LOG2E = 1.4426950408889634f;
constexpr float EPS = 1e-6f;
constexpr size_t MiB = 1u << 20;
constexpr size_t WS_WIN = 1 * MiB, WS_WBR_RNN = 17 * MiB, WS_WBR_DIFF = 19 * MiB, WS_WBR_FOX = 21 * MiB, WS_WOUT = 23 * MiB, WS_WUP = 25 * MiB,
                 WS_WDOWN = 36 * MiB, WS_RGR = 42 * MiB, WS_RGI = 42 * MiB + 256 * 1024, WS_SUMSQ = 43 * MiB, WS_C = 44 * MiB, WS_LOGF = 45 * MiB, WS_H = 46 * MiB, WS_P = 110 * MiB,
                 WS_XG = WS_P, WS_ACT = 174 * MiB, WS_HALO = 350 * MiB, WS_END = 430 * MiB;
constexpr int LDS_BYTES = 147456;
constexpr int MHALF = MTOK / 2;

__device__ __forceinline__ unsigned f2bf(float f) { unsigned u = __builtin_bit_cast(unsigned, f); return (u + 0x7fffu + ((u >> 16) & 1u)) >> 16; }
__device__ __forceinline__ unsigned pk2(float lo, float hi) { return f2bf(lo) | (f2bf(hi) << 16); }
__device__ __forceinline__ float bf2f(unsigned short b) { return __builtin_bit_cast(float, (unsigned)b << 16); }
__device__ __forceinline__ float bflo(unsigned w) { return __builtin_bit_cast(float, w << 16); }
__device__ __forceinline__ float bfhi(unsigned w) { return __builtin_bit_cast(float, w & 0xffff0000u); }
typedef __bf16 bf16x2_t __attribute__((ext_vector_type(2)));
__device__ __forceinline__ unsigned cvt_pk_bf16(float lo, float hi) { const f32x2 v = {lo, hi}; const bf16x2_t b = __builtin_convertvector(v, bf16x2_t); return __builtin_bit_cast(unsigned, b); }
__device__ __forceinline__ float fast_exp2(float x) { return __builtin_amdgcn_exp2f(x); }
__device__ __forceinline__ float fast_rcp(float x) { return __builtin_amdgcn_rcpf(x); }
__device__ __forceinline__ float fast_log2(float x) { return __builtin_amdgcn_logf(x); }
__device__ __forceinline__ float fast_rsq(float x) { return __builtin_amdgcn_rsqf(x); }
__device__ __forceinline__ float log1p_small(float e) { return e < 0.01f ? e * (1.0f - e * (0.5f - e * 0.33333334f)) : fast_log2(1.0f + e) * 0.6931471806f; }
__device__ __forceinline__ float sigmoidf_(float x) { return fast_rcp(1.0f + fast_exp2(-x * LOG2E)); }
__device__ __forceinline__ float gelu_tanh(float x) { const float t = x + 0.044715f * x * x * x; return x * fast_rcp(1.0f + fast_exp2(-2.3022082f * t)); }
__device__ __forceinline__ float wave_sum(float v) {
#pragma unroll
    for (int o = 1; o < 64; o <<= 1) v += __shfl_xor(v, o);
    return v;
}
__device__ __forceinline__ int launder_tid() { int t = threadIdx.x; asm volatile("" : "+v"(t)); return t; }
template <class T> __device__ __forceinline__ T* launder_ptr(T* p) { asm volatile("" : "+s"(p)); return p; }
__device__ __forceinline__ int crow(int r, int hi) { return (r & 3) + 8 * (r >> 2) + 4 * hi; }

namespace pg8 {
constexpr int BM = 256, BK = 64, HALF = 128, HTB = HALF * BK * 2, STAGE_BYTES = 8 * HTB, NXCD = 8, WGM = 8;
__host__ __device__ __forceinline__ int lds_byte(int r, int c) { const int st = (r >> 4) * 2 + (c >> 5), rr = r & 15, cc = c & 31, ob = rr * 64 + cc * 2; return st * 1024 + (ob ^ (((ob >> 9) & 1) << 5)); }
__host__ __device__ __forceinline__ void stage_rc(int b, int& R, int& C) { const int st = b / 1024, sb = b % 1024, swz = sb ^ (((sb >> 9) & 1) << 5); R = (st >> 1) * 16 + swz / 64; C = (st & 1) * 32 + (swz % 64) / 2; }
__host__ __device__ __forceinline__ int perm32(int rho) { const int n = rho >> 4, i = rho & 15; return 8 * (i >> 2) + 4 * n + (i & 3); }

struct Unit { int pm, pn; };
struct Gemm { const bf16_t* A; const bf16_t* Bt; int lda, ldb, M, N, K; };

struct StaticOrder {
    int nM, nN, nwg, G, c;
    __host__ __device__ void init(int M, int N, int G_, int c_) { nM = M / BM; nN = N / BM; nwg = nM * nN; G = G_; c = c_; }
    __host__ __device__ bool next(int i, Unit& u) const {
        const long L = (long)i * G + c; if (L >= nwg) return false;
        int wgid = (int)L; { const int q = nwg / NXCD, r = nwg % NXCD, xcd = wgid % NXCD, off = wgid / NXCD; wgid = (xcd < r ? xcd * (q + 1) : r * (q + 1) + (xcd - r) * q) + off; }
        const int nig = WGM * nN, gid = wgid / nig, fm = gid * WGM, gsz = (nM - fm) < WGM ? (nM - fm) : WGM;
        u.pm = fm + ((wgid % nig) % gsz); u.pn = (wgid % nig) / gsz; return true;
    }
};

template <class Epi, class Sched>
__device__ __forceinline__ void gemm_phase(LAS unsigned char* lds, const Gemm g, const Sched& S, const Epi& E) {
    const int tid = launder_tid(), wid = __builtin_amdgcn_readfirstlane(tid >> 6), lane = tid & 63, wr = wid >> 2, wc = wid & 3, fr = lane & 15, fq = lane >> 4;
    const int K = g.K, nt = K / BK;
    unsigned voffA[2], voffB[2];
#pragma unroll
    for (int i = 0; i < 2; ++i) { int R, C; stage_rc(tid * 16 + i * 8192, R, C); const int Rb = (R & ~31) + perm32(R & 31);
        voffA[i] = (unsigned)(R * g.lda + C) * 2u; voffB[i] = (unsigned)(Rb * g.ldb + C) * 2u; }
    const size_t kstep = (size_t)(BK * 2);
    const size_t hstepA = (size_t)HALF * g.lda * 2, hstepB = (size_t)HALF * g.ldb * 2;
    const size_t tstepA = 2 * hstepA, tstepB = 2 * hstepB;
    const unsigned ldsw = (unsigned)wid * 1024u;
    const int aoff = lds_byte(wr * 64 + fr, fq * 8), boff = lds_byte(wc * 32 + fr, fq * 8);
#define PG8_SA(b, h) (((b) * 2 + (h)) * HTB)
#define PG8_SB(b, h) ((4 + (b) * 2 + (h)) * HTB)
#define PG8_STAGE(bufoff, gbase, voff) do { _Pragma("unroll") for (int _i = 0; _i < 2; ++_i) \
        __builtin_amdgcn_global_load_lds((const unsigned*)((const char*)(gbase) + (voff)[_i]), (LAS unsigned*)(lds + (bufoff) + ldsw + _i * 8192), 16, 0, 0); } while (0)
#define PG8_LDA(dst, b, h) do { _Pragma("unroll") for (int m = 0; m < 4; ++m) _Pragma("unroll") for (int k = 0; k < 2; ++k) dst[m][k] = *(const LAS bf16x8*)(lds + PG8_SA(b, h) + aoff + m * 2048 + k * 1024); } while (0)
#define PG8_LDB(dst, b, h) do { _Pragma("unroll") for (int n = 0; n < 2; ++n) _Pragma("unroll") for (int k = 0; k < 2; ++k) dst[n][k] = *(const LAS bf16x8*)(lds + PG8_SB(b, h) + boff + n * 2048 + k * 1024); } while (0)
#define PG8_MMA(ai, bj, At, Bt) do { __builtin_amdgcn_s_setprio(1); _Pragma("unroll") for (int m = 0; m < 4; ++m) _Pragma("unroll") for (int n = 0; n < 2; ++n) _Pragma("unroll") for (int k = 0; k < 2; ++k) \
        acc[ai][bj][m][n] = __builtin_amdgcn_mfma_f32_16x16x32_bf16(Bt[n][k], At[m][k], acc[ai][bj][m][n], 0, 0, 0); __builtin_amdgcn_s_setprio(0); } while (0)
#define PG8_WAIT_V(n) asm volatile("s_waitcnt vmcnt(" #n ")" ::: "memory")
#define PG8_WAIT_L(n) asm volatile("s_waitcnt lgkmcnt(" #n ")" ::: "memory")
#define PG8_BAR __builtin_amdgcn_s_barrier()
#define PG8_SCHED __builtin_amdgcn_sched_barrier(0)
    Unit cur, nxt; int ui = 0;
    if (!S.next(0, cur)) return;
    f32x4 acc[2][2][4][2];
#pragma unroll
    for (int a = 0; a < 2; ++a)
#pragma unroll
        for (int b = 0; b < 2; ++b)
#pragma unroll
            for (int m = 0; m < 4; ++m)
#pragma unroll
                for (int n = 0; n < 2; ++n) acc[a][b][m][n] = (f32x4){0.f, 0.f, 0.f, 0.f};
    bf16x8 At[4][2], B0[2][2], B1[2][2];
    const char* cA = (const char*)g.A + (size_t)cur.pm * tstepA; const char* cB = (const char*)g.Bt + (size_t)cur.pn * tstepB;
    PG8_STAGE(PG8_SB(0, 0), cB, voffB); PG8_STAGE(PG8_SB(0, 1), cB + hstepB, voffB); PG8_STAGE(PG8_SA(0, 0), cA, voffA); PG8_STAGE(PG8_SA(0, 1), cA + hstepA, voffA);
    if (wr == 1) PG8_BAR;
    PG8_WAIT_V(2); PG8_BAR;
    PG8_STAGE(PG8_SB(1, 0), cB + kstep, voffB); PG8_STAGE(PG8_SA(1, 0), cA + kstep, voffA); PG8_STAGE(PG8_SB(1, 1), cB + hstepB + kstep, voffB);
    PG8_WAIT_V(6); PG8_BAR;
    for (;;) {
        const bool has_next = S.next(ui + 1, nxt);
        const char* nA = has_next ? (const char*)g.A + (size_t)nxt.pm * tstepA : cA; const char* nB = has_next ? (const char*)g.Bt + (size_t)nxt.pn * tstepB : cB;
        for (int t = 0; t < nt; t += 2) {
            const bool last = (t == nt - 2);
            const char* a1 = cA + (size_t)(t + 1) * kstep;
            const char* a2 = last ? nA : cA + (size_t)(t + 2) * kstep; const char* b2 = last ? nB : cB + (size_t)(t + 2) * kstep;
            const char* a3 = a2 + kstep; const char* b3 = b2 + kstep;
            PG8_LDB(B0, 0, 0); PG8_LDB(B1, 0, 1); PG8_SCHED; PG8_LDA(At, 0, 0); PG8_STAGE(PG8_SA(1, 1), a1 + hstepA, voffA);
            PG8_WAIT_V(8); PG8_WAIT_L(0); PG8_BAR; PG8_MMA(0, 0, At, B0); PG8_MMA(0, 1, At, B1); PG8_BAR; PG8_SCHED;
            PG8_LDA(At, 0, 1); PG8_STAGE(PG8_SB(0, 0), b2, voffB); PG8_STAGE(PG8_SB(0, 1), b2 + hstepB, voffB); PG8_STAGE(PG8_SA(0, 0), a2, voffA);
            PG8_WAIT_V(8); PG8_WAIT_L(0); PG8_BAR; PG8_MMA(1, 0, At, B0); PG8_MMA(1, 1, At, B1); PG8_BAR; PG8_SCHED;
            PG8_LDB(B0, 1, 0); PG8_LDB(B1, 1, 1); PG8_SCHED; PG8_LDA(At, 1, 0); PG8_STAGE(PG8_SA(0, 1), a2 + hstepA, voffA);
            PG8_WAIT_V(8); PG8_WAIT_L(0); PG8_BAR; PG8_MMA(0, 0, At, B0); PG8_MMA(0, 1, At, B1); PG8_BAR; PG8_SCHED;
            PG8_LDA(At, 1, 1); PG8_STAGE(PG8_SB(1, 0), b3, voffB); PG8_STAGE(PG8_SB(1, 1), b3 + hstepB, voffB); PG8_STAGE(PG8_SA(1, 0), a3, voffA);
            PG8_WAIT_V(8); PG8_WAIT_L(0); PG8_BAR; PG8_MMA(1, 0, At, B0); PG8_MMA(1, 1, At, B1); PG8_BAR; PG8_SCHED;
        }
        if (wr == 0) PG8_BAR;
        E(acc, cur, wr, wc, fr, fq);
        if (!has_next) break;
#pragma unroll
        for (int a = 0; a < 2; ++a)
#pragma unroll
            for (int b = 0; b < 2; ++b)
#pragma unroll
                for (int m = 0; m < 4; ++m)
#pragma unroll
                    for (int n = 0; n < 2; ++n) acc[a][b][m][n] = (f32x4){0.f, 0.f, 0.f, 0.f};
        cur = nxt; cA = nA; cB = nB; ++ui;
        if (wr == 1) PG8_BAR;
    }
    PG8_WAIT_V(0);
    PG8_BAR;
#undef PG8_SA
#undef PG8_SB
#undef PG8_STAGE
#undef PG8_LDA
#undef PG8_LDB
#undef PG8_MMA
#undef PG8_WAIT_V
#undef PG8_WAIT_L
#undef PG8_BAR
#undef PG8_SCHED
}

struct Gemm3 { const bf16_t* Abase; const bf16_t* Bbase; int ldb;
    __device__ __forceinline__ const bf16_t* A(int s) const { return Abase + (O_GR + (size_t)s * (O_DQ - O_GR) + (size_t)(s >> 1) * (O_FQ + O_GR - 2 * O_DQ)); }
    __device__ __forceinline__ int lda(int s) const { return s ? QP : XP; }
    __device__ __forceinline__ const bf16_t* B(int s) const { return Bbase + (size_t)s * (2u << 20) / 2; }
    __device__ __forceinline__ int nt(int s) const { return 16 >> ((s + 1) >> 1); } };
template <class Epi, class Sched>
__device__ __forceinline__ void gemm_phase3(LAS unsigned char* lds, const Gemm3 g, const Sched& S, const Epi& E) {
    const int tid = launder_tid(), wid = __builtin_amdgcn_readfirstlane(tid >> 6), lane = tid & 63, wr = wid >> 2, wc = wid & 3, fr = lane & 15, fq = lane >> 4;
    unsigned voffAx[2], voffAq[2], voffB[2];
#pragma unroll
    for (int i = 0; i < 2; ++i) { int R, C; stage_rc(tid * 16 + i * 8192, R, C); const int Rb = (R & ~31) + perm32(R & 31);
        voffAx[i] = (unsigned)(R * XP + C) * 2u; voffAq[i] = (unsigned)(R * QP + C) * 2u; voffB[i] = (unsigned)(Rb * g.ldb + C) * 2u; }
    const size_t kstep = (size_t)(BK * 2);
    const size_t hstepB = (size_t)HALF * g.ldb * 2, tstepB = 2 * hstepB;
    constexpr size_t hstepAx = (size_t)HALF * XP * 2, hstepAq = (size_t)HALF * QP * 2;
    const unsigned ldsw = (unsigned)wid * 1024u;
    const int aoff = lds_byte(wr * 64 + fr, fq * 8), boff = lds_byte(wc * 32 + fr, fq * 8);
#define PG8_SA(b, h) (((b) * 2 + (h)) * HTB)
#define PG8_SB(b, h) ((4 + (b) * 2 + (h)) * HTB)
#define PG8_STAGE(bufoff, gbase, voff) do { _Pragma("unroll") for (int _i = 0; _i < 2; ++_i) \
        __builtin_amdgcn_global_load_lds((const unsigned*)((const char*)(gbase) + (voff)[_i]), (LAS unsigned*)(lds + (bufoff) + ldsw + _i * 8192), 16, 0, 0); } while (0)
#define PG8_LDA(dst, b, h) do { _Pragma("unroll") for (int m = 0; m < 4; ++m) _Pragma("unroll") for (int k = 0; k < 2; ++k) dst[m][k] = *(const LAS bf16x8*)(lds + PG8_SA(b, h) + aoff + m * 2048 + k * 1024); } while (0)
#define PG8_LDB(dst, b, h) do { _Pragma("unroll") for (int n = 0; n < 2; ++n) _Pragma("unroll") for (int k = 0; k < 2; ++k) dst[n][k] = *(const LAS bf16x8*)(lds + PG8_SB(b, h) + boff + n * 2048 + k * 1024); } while (0)
#define PG8_MMA(ai, bj, At, Bt) do { __builtin_amdgcn_s_setprio(1); _Pragma("unroll") for (int m = 0; m < 4; ++m) _Pragma("unroll") for (int n = 0; n < 2; ++n) _Pragma("unroll") for (int k = 0; k < 2; ++k) \
        acc[ai][bj][m][n] = __builtin_amdgcn_mfma_f32_16x16x32_bf16(Bt[n][k], At[m][k], acc[ai][bj][m][n], 0, 0, 0); __builtin_amdgcn_s_setprio(0); } while (0)
#define PG8_WAIT_V(n) asm volatile("s_waitcnt vmcnt(" #n ")" ::: "memory")
#define PG8_WAIT_L(n) asm volatile("s_waitcnt lgkmcnt(" #n ")" ::: "memory")
#define PG8_BAR __builtin_amdgcn_s_barrier()
#define PG8_SCHED __builtin_amdgcn_sched_barrier(0)
    Unit cur, nxt; int ui = 0, seg = 0;
    if (!S.next(0, cur)) return;
    f32x4 acc[2][2][4][2];
#pragma unroll
    for (int a = 0; a < 2; ++a)
#pragma unroll
        for (int b = 0; b < 2; ++b)
#pragma unroll
            for (int m = 0; m < 4; ++m)
#pragma unroll
                for (int n = 0; n < 2; ++n) acc[a][b][m][n] = (f32x4){0.f, 0.f, 0.f, 0.f};
    bf16x8 At[4][2], B0[2][2], B1[2][2];
    const char* cA = (const char*)g.A(0) + (size_t)cur.pm * (2 * hstepAx); const char* cB = (const char*)g.B(0) + (size_t)cur.pn * tstepB;
    int nt = g.nt(0);
    unsigned voffA[2] = {voffAx[0], voffAx[1]}; size_t hstepA = hstepAx;
    PG8_STAGE(PG8_SB(0, 0), cB, voffB); PG8_STAGE(PG8_SB(0, 1), cB + hstepB, voffB); PG8_STAGE(PG8_SA(0, 0), cA, voffA); PG8_STAGE(PG8_SA(0, 1), cA + hstepA, voffA);
    if (wr == 1) PG8_BAR;
    PG8_WAIT_V(2); PG8_BAR;
    PG8_STAGE(PG8_SB(1, 0), cB + kstep, voffB); PG8_STAGE(PG8_SA(1, 0), cA + kstep, voffA); PG8_STAGE(PG8_SB(1, 1), cB + hstepB + kstep, voffB);
    PG8_WAIT_V(6); PG8_BAR;
    for (;;) {
        const int nseg = (seg == 2) ? 0 : seg + 1;
        bool has_next = true; if (seg == 2) has_next = S.next(ui + 1, nxt); else nxt = cur;
        const size_t nhstepA = has_next ? (nseg ? hstepAq : hstepAx) : hstepA;
        unsigned nvoffA[2]; nvoffA[0] = has_next ? (nseg ? voffAq[0] : voffAx[0]) : voffA[0]; nvoffA[1] = has_next ? (nseg ? voffAq[1] : voffAx[1]) : voffA[1];
        const char* nA = has_next ? (const char*)g.A(nseg) + (size_t)nxt.pm * (2 * nhstepA) : cA; const char* nB = has_next ? (const char*)g.B(nseg) + (size_t)nxt.pn * tstepB : cB;
        for (int t = 0; t < nt; t += 2) {
            const bool last = (t == nt - 2);
            const char* a1 = cA + (size_t)(t + 1) * kstep;
            const char* a2 = last ? nA : cA + (size_t)(t + 2) * kstep; const char* b2 = last ? nB : cB + (size_t)(t + 2) * kstep;
            const char* a3 = a2 + kstep; const char* b3 = b2 + kstep;
            unsigned vA2[2]; vA2[0] = last ? nvoffA[0] : voffA[0]; vA2[1] = last ? nvoffA[1] : voffA[1]; const size_t hA2 = last ? nhstepA : hstepA;
            PG8_LDB(B0, 0, 0); PG8_LDB(B1, 0, 1); PG8_SCHED; PG8_LDA(At, 0, 0); PG8_STAGE(PG8_SA(1, 1), a1 + hstepA, voffA);
            PG8_WAIT_V(8); PG8_WAIT_L(0); PG8_BAR; PG8_MMA(0, 0, At, B0); PG8_MMA(0, 1, At, B1); PG8_BAR; PG8_SCHED;
            PG8_LDA(At, 0, 1); PG8_STAGE(PG8_SB(0, 0), b2, voffB); PG8_STAGE(PG8_SB(0, 1), b2 + hstepB, voffB); PG8_STAGE(PG8_SA(0, 0), a2, vA2);
            PG8_WAIT_V(8); PG8_WAIT_L(0); PG8_BAR; PG8_MMA(1, 0, At, B0); PG8_MMA(1, 1, At, B1); PG8_BAR; PG8_SCHED;
            PG8_LDB(B0, 1, 0); PG8_LDB(B1, 1, 1); PG8_SCHED; PG8_LDA(At, 1, 0); PG8_STAGE(PG8_SA(0, 1), a2 + hA2, vA2);
            PG8_WAIT_V(8); PG8_WAIT_L(0); PG8_BAR; PG8_MMA(0, 0, At, B0); PG8_MMA(0, 1, At, B1); PG8_BAR; PG8_SCHED;
            PG8_LDA(At, 1, 1); PG8_STAGE(PG8_SB(1, 0), b3, voffB); PG8_STAGE(PG8_SB(1, 1), b3 + hstepB, voffB); PG8_STAGE(PG8_SA(1, 0), a3, vA2);
            PG8_WAIT_V(8); PG8_WAIT_L(0); PG8_BAR; PG8_MMA(1, 0, At, B0); PG8_MMA(1, 1, At, B1); PG8_BAR; PG8_SCHED;
        }
        if (wr == 0) PG8_BAR;
        E(acc, cur, seg, wr, wc, fr, fq);
        if (!has_next) break;
        if (seg == 2) {
#pragma unroll
        for (int a = 0; a < 2; ++a)
#pragma unroll
            for (int b = 0; b < 2; ++b)
#pragma unroll
                for (int m = 0; m < 4; ++m)
#pragma unroll
                    for (int n = 0; n < 2; ++n) acc[a][b][m][n] = (f32x4){0.f, 0.f, 0.f, 0.f};
        ++ui; }
        cur = nxt; cA = nA; cB = nB; seg = nseg; nt = g.nt(seg); voffA[0] = nvoffA[0]; voffA[1] = nvoffA[1]; hstepA = nhstepA;
        if (wr == 1) PG8_BAR;
    }
    PG8_WAIT_V(0);
    PG8_BAR;
#undef PG8_SA
#undef PG8_SB
#undef PG8_STAGE
#undef PG8_LDA
#undef PG8_LDB
#undef PG8_MMA
#undef PG8_WAIT_V
#undef PG8_WAIT_L
#undef PG8_BAR
#undef PG8_SCHED
}

#define EPI_LOOP_BEGIN \
    const int row0 = u.pm * BM + wr * 64 + fr; const int colt = u.pn * BM + wc * 32 + 8 * fq; \
    _Pragma("unroll") for (int ai = 0; ai < 2; ++ai) _Pragma("unroll") for (int m = 0; m < 4; ++m) { const int row = row0 + ai * HALF + m * 16; \
        _Pragma("unroll") for (int bj = 0; bj < 2; ++bj) { const int col = colt + bj * HALF; f32x4 v0 = acc[ai][bj][m][0], v1 = acc[ai][bj][m][1];
#define EPI_LOOP_END } if (m == 3) asm volatile("" ::: "memory"); }

__device__ __forceinline__ u32x4 pack8(f32x4 v0, f32x4 v1) { u32x4 w; w.x = cvt_pk_bf16(v0[0], v0[1]); w.y = cvt_pk_bf16(v0[2], v0[3]); w.z = cvt_pk_bf16(v1[0], v1[1]); w.w = cvt_pk_bf16(v1[2], v1[3]); return w; }

struct EpiProj {
    bf16_t* O;
    __device__ __forceinline__ void operator()(f32x4 (&acc)[2][2][4][2], const Unit& u, int wr, int wc, int fr, int fq) const {
        const int pn = u.pn; const int mode = (pn >= 4 && pn < 8) ? 1 : ((pn == 8 || pn == 9 || pn == 14 || pn == 15) ? 2 : 0);
        const float qs = 0.125f * LOG2E;
        const int q_ = pn - 8; const int pitch = (pn < 8) ? XP : QP;
        bf16_t* dst = (pn < 8) ? O + (size_t)(pn >> 2) * (MT * XP) + (pn & 3) * 256 : O + O_DQ + (size_t)(q_ >> 1) * (MT * QP) + (q_ & 1) * 256;
        EPI_LOOP_BEGIN
            if (mode == 1) {
#pragma unroll
                for (int e = 0; e < 4; ++e) { v0[e] = gelu_tanh(v0[e]); v1[e] = gelu_tanh(v1[e]); }
            } else if (mode == 2) { v0 = v0 * qs; v1 = v1 * qs; }
            *(u32x4*)(dst + (size_t)row * pitch + (col - u.pn * BM)) = pack8(v0, v1);
        EPI_LOOP_END
    }
};
__device__ __forceinline__ size_t gate_frag_off(int pm, int pnl, int wave, int ai, int m, int bj, int lane, size_t gbase) {
    const int blk = (((pm * 4 + pnl) * 8 + wave) * 16) + ((ai * 4 + m) * 2 + bj);
    return gbase + (size_t)blk * 512 + lane * 8;
}
struct EpiGates {
    bf16_t* O; const float* gb;
    __device__ __forceinline__ void operator()(f32x4 (&acc)[2][2][4][2], const Unit& u, int wr, int wc, int fr, int fq) const {
        const int b = u.pn >> 2; const size_t cbase = (size_t)b * (b == 1 ? O_DK : O_FK / 2);     const int wave = wr * 4 + wc, lane = fq * 16 + fr;
        EPI_LOOP_BEGIN
            (void)row;
            const f32x4 b0 = *(const f32x4*)(gb + col), b1 = *(const f32x4*)(gb + col + 4);
#pragma unroll
            for (int e = 0; e < 4; ++e) { v0[e] = sigmoidf_(v0[e] + b0[e]); v1[e] = sigmoidf_(v1[e] + b1[e]); }
            *(u32x4*)(O + gate_frag_off(u.pm, u.pn & 3, wave, ai, m, bj, lane, cbase)) = pack8(v0, v1);
        EPI_LOOP_END
    }
};
struct EpiResid {
    const float* in; float* out; int rowoff;
    __device__ __forceinline__ void operator()(f32x4 (&acc)[2][2][4][2], const Unit& u, int wr, int wc, int fr, int fq) const {
        EPI_LOOP_BEGIN
            const size_t off = (size_t)(row + rowoff) * DM + col;
            const f32x4 a0 = *(const f32x4*)(in + off), a1 = *(const f32x4*)(in + off + 4);
            *(f32x4*)(out + off) = a0 + v0; *(f32x4*)(out + off + 4) = a1 + v1;
        EPI_LOOP_END
    }
};
struct EpiStore {
    bf16_t* O; int ldc;
    __device__ __forceinline__ void operator()(f32x4 (&acc)[2][2][4][2], const Unit& u, int wr, int wc, int fr, int fq) const {
        EPI_LOOP_BEGIN
            *(u32x4*)(O + (size_t)row * ldc + col) = pack8(v0, v1);
        EPI_LOOP_END
    }
};

__device__ __forceinline__ float dpp_ror1(float x) { return __builtin_bit_cast(float, __builtin_amdgcn_mov_dpp(__builtin_bit_cast(int, x), 0x121, 0xf, 0xf, true)); }
__device__ __forceinline__ float dpp_ror2(float x) { return __builtin_bit_cast(float, __builtin_amdgcn_mov_dpp(__builtin_bit_cast(int, x), 0x122, 0xf, 0xf, true)); }

struct EpiResidNorm {
    const float* in; float* out; bf16_t* xg; const float* g; float* sumsq;
    __device__ __forceinline__ void operator()(f32x4 (&acc)[2][2][4][2], const Unit& u, int wr, int wc, int fr, int fq) const {
        const int row0 = u.pm * BM + wr * 64 + fr; const int colt = u.pn * BM + wc * 32 + 8 * fq;
#pragma unroll
        for (int ai = 0; ai < 2; ++ai)
#pragma unroll
            for (int m = 0; m < 4; ++m) { const int row = row0 + ai * HALF + m * 16; float ss = 0.f;
#pragma unroll
                for (int bj = 0; bj < 2; ++bj) { const int col = colt + bj * HALF; const size_t off = (size_t)row * DM + col;
                    const f32x4 x0 = *(const f32x4*)(in + off) + acc[ai][bj][m][0], x1 = *(const f32x4*)(in + off + 4) + acc[ai][bj][m][1];
                    *(f32x4*)(out + off) = x0; *(f32x4*)(out + off + 4) = x1;
                    const f32x4 g0 = *(const f32x4*)(g + col), g1 = *(const f32x4*)(g + col + 4);
                    *(u32x4*)(xg + off) = pack8(x0 * g0, x1 * g1);
                    ss += (x0[0] * x0[0] + x0[1] * x0[1]) + (x0[2] * x0[2] + x0[3] * x0[3]) + (x1[0] * x1[0] + x1[1] * x1[1]) + (x1[2] * x1[2] + x1[3] * x1[3]); }
                ss += __shfl_xor(ss, 16); ss += __shfl_xor(ss, 32);
                if (fq == 0) atomicAdd(sumsq + row, ss);
                if (m == 3) asm volatile("" ::: "memory"); }
    }
};

struct EpiFfn {
    bf16_t* act; float* halo; const float* cw; const float* cb; const float* sumsq;
    __device__ __forceinline__ void operator()(f32x4 (&acc)[2][2][4][2], const Unit& u, int wr, int wc, int fr, int fq) const {
        float rs[2][4];
#pragma unroll
        for (int ai = 0; ai < 2; ++ai)
#pragma unroll
            for (int m = 0; m < 4; ++m) rs[ai][m] = fast_rsq(sumsq[u.pm * BM + ai * HALF + wr * 64 + m * 16 + fr] * (1.0f / DM) + EPS);
#pragma unroll
        for (int n = 0; n < 2; ++n) {
            const int ch0 = u.pn * 128 + wc * 32 + 8 * fq + 4 * n;
            const f32x4 wg0 = *(const f32x4*)(cw + ch0), wg1 = *(const f32x4*)(cw + DFF2 + ch0), wg2 = *(const f32x4*)(cw + 2 * DFF2 + ch0), bg = *(const f32x4*)(cb + ch0);
            const f32x4 wv0 = *(const f32x4*)(cw + DFF + ch0), wv1 = *(const f32x4*)(cw + DFF2 + DFF + ch0), wv2 = *(const f32x4*)(cw + 2 * DFF2 + DFF + ch0), bv = *(const f32x4*)(cb + DFF + ch0);
#pragma unroll
            for (int ai = 0; ai < 2; ++ai) {
                const int blk = u.pm * 4 + ai * 2 + wr;
                f32x4 pg = {0.f, 0.f, 0.f, 0.f}, pv = {0.f, 0.f, 0.f, 0.f};
#pragma unroll
                for (int m = 0; m < 4; ++m) {
                    const int row = u.pm * BM + ai * HALF + wr * 64 + m * 16 + fr;
                    const f32x4 gq = acc[ai][0][m][n] * rs[ai][m], vq = acc[ai][1][m][n] * rs[ai][m];
                    f32x4 g1, g2, v1, v2;
#pragma unroll
                    for (int e = 0; e < 4; ++e) {
                        g1[e] = dpp_ror1(fr == 15 ? pg[e] : gq[e]); g2[e] = dpp_ror2(fr >= 14 ? pg[e] : gq[e]); v1[e] = dpp_ror1(fr == 15 ? pv[e] : vq[e]); v2[e] = dpp_ror2(fr >= 14 ? pv[e] : vq[e]); }
                    const f32x4 cg = bg + wg0 * g2 + wg1 * g1 + wg2 * gq, cv = bv + wv0 * v2 + wv1 * v1 + wv2 * vq;
                    {
                        u32x2 w; w.x = cvt_pk_bf16(gelu_tanh(cg[0]) * cv[0], gelu_tanh(cg[1]) * cv[1]); w.y = cvt_pk_bf16(gelu_tanh(cg[2]) * cv[2], gelu_tanh(cg[3]) * cv[3]);
                        *(u32x2*)(act + (size_t)row * DFF + ch0) = w; }
                    if (m == 0 && fr < 2) { float* hp = halo + ((size_t)blk * 4 + fr) * DFF2 + ch0; *(f32x4*)hp = gq; *(f32x4*)(hp + DFF) = vq; }
                    if (m == 3 && fr >= 14) { float* hp = halo + ((size_t)blk * 4 + fr - 12) * DFF2 + ch0; *(f32x4*)hp = gq; *(f32x4*)(hp + DFF) = vq; }
                    pg = gq; pv = vq;
                }
                asm volatile("" ::: "memory");
            }
        }
    }
};
struct EpiMerge3 {
    const bf16_t* P; bf16_t* Mb;
    __device__ __forceinline__ void operator()(f32x4 (&acc)[2][2][4][2], const Unit& u, int seg, int wr, int wc, int fr, int fq) const {
        const size_t ga = (size_t)seg * (seg == 1 ? O_DK : O_FK / 2), gb = (seg == 0 ? O_DK : O_FK); const int wave = wr * 4 + wc, lane = fq * 16 + fr;
        const int row0 = u.pm * BM + wr * 64 + fr; const int colt = u.pn * BM + wc * 32 + 8 * fq;
#pragma unroll
        for (int ai = 0; ai < 2; ++ai)
#pragma unroll
            for (int m = 0; m < 4; ++m) { const int row = row0 + ai * HALF + m * 16;
#pragma unroll
                for (int bj = 0; bj < 2; ++bj) { const int col = colt + bj * HALF;
                    const u32x4 aw = *(const u32x4*)(P + gate_frag_off(u.pm, u.pn, wave, ai, m, bj, lane, ga));
                    f32x4 s0 = {bflo(aw.x), bfhi(aw.x), bflo(aw.y), bfhi(aw.y)}, s1 = {bflo(aw.z), bfhi(aw.z), bflo(aw.w), bfhi(aw.w)};
                    if (seg != 2) { const u32x4 bw = *(const u32x4*)(P + gate_frag_off(u.pm, u.pn, wave, ai, m, bj, lane, gb));
                        const f32x4 d0 = {bflo(bw.x), bfhi(bw.x), bflo(bw.y), bfhi(bw.y)}, d1 = {bflo(bw.z), bfhi(bw.z), bflo(bw.w), bfhi(bw.w)};
#pragma unroll
                        for (int e = 0; e < 4; ++e) { s0[e] *= fast_rcp(d0[e]); s1[e] *= fast_rcp(d1[e]); } }
                    acc[ai][bj][m][0] *= s0; acc[ai][bj][m][1] *= s1;
                    if (seg == 2) *(u32x4*)(Mb + (size_t)row * DM + col) = pack8(acc[ai][bj][m][0], acc[ai][bj][m][1]); }
                if (m == 3) asm volatile("" ::: "memory"); }
    }
};
}

struct Params { const float* in[28]; float* out; unsigned char* ws; };
enum { I_X = 0, I_N1G, I_WIN, I_RCW, I_RCB, I_RGWR, I_RGBR, I_RGWI, I_RGBI, I_RGA, I_LQ1, I_LK1, I_LQ2, I_LK2, I_SUBG, I_REL, I_FOXB, I_GATEB,
       I_WBR_RNN, I_WBR_DIFF, I_WBR_FOX, I_WOUT, I_N2G, I_FUP, I_FCW, I_FCB, I_FDOWN, I_FINALG };

__constant__ unsigned char T5_BUCKET[128] = {0, 1, 2, 3, 4, 5, 6, 7, 8, 9, 10, 11, 12, 13, 14, 15, 16, 16, 16, 17, 17, 18, 18, 18, 19, 19, 19, 20, 20, 20, 20, 21, 21, 21, 21, 22, 22, 22, 22, 22, 23, 23, 23, 23, 23, 23, 24, 24, 24, 24, 24, 24, 25, 25, 25, 25, 25, 25, 25, 26, 26, 26, 26, 26, 26, 26, 26, 27, 27, 27, 27, 27, 27, 27, 27, 27, 27, 28, 28, 28, 28, 28, 28, 28, 28, 28, 28, 29, 29, 29, 29, 29, 29, 29, 29, 29, 29, 29, 29, 30, 30, 30, 30, 30, 30, 30, 30, 30, 30, 30, 30, 30, 30, 31, 31, 31, 31, 31, 31, 31, 31, 31, 31, 31, 31, 31, 31, 31};

template <bool FFN_PERM = false>
__device__ __forceinline__ void transpose_item(const float* W, int ldw, int K, bf16_t* WT, int nblk, int item, LAS float* scr, int lane) {
    const int kb = item / nblk, nb = item % nblk, k0 = 64 * kb, n0 = 32 * nb;
    const int d0 = FFN_PERM ? ((n0 < DFF) ? ((n0 >> 7) * 256 + (n0 & 127)) : ((((n0 - DFF) >> 7) * 256) + 128 + ((n0 - DFF) & 127))) : n0;
#pragma unroll 8
    for (int i = 0; i < 32; ++i) { const int kk = 2 * i + (lane >> 5); scr[kk * 33 + (lane & 31)] = W[(size_t)(k0 + kk) * ldw + n0 + (lane & 31)]; }
    asm volatile("s_waitcnt lgkmcnt(0)" ::: "memory");
    const int c = lane & 7;
#pragma unroll
    for (int j = 0; j < 4; ++j) { const int n = (lane >> 3) + 8 * j; const LAS float* s = scr + (8 * c) * 33 + n;
        u32x4 o; o.x = pk2(s[0 * 33], s[1 * 33]); o.y = pk2(s[2 * 33], s[3 * 33]); o.z = pk2(s[4 * 33], s[5 * 33]); o.w = pk2(s[6 * 33], s[7 * 33]);
        *(u32x4*)(WT + (size_t)(d0 + n) * K + k0 + 8 * c) = o; }
    asm volatile("s_waitcnt lgkmcnt(0)" ::: "memory");
}

__device__ __forceinline__ void convert_weights(const Params& P, int l, LAS unsigned char* lds, int gw, int NGW, int wid, int lane) {
    LAS float* scr = (LAS float*)(lds + wid * 8704);
    unsigned char* ws = launder_ptr(P.ws);
    constexpr int I0 = 16 * 160, I1 = 16 * 96, I2 = 16 * 32, I3 = 8 * 32, I4 = 8 * 32, I5 = 16 * 32, I6 = 16 * 176, I7 = 44 * 32, I8 = 64, I9 = 64;
    constexpr int NITEMS = I0 + I1 + I2 + I3 + I4 + I5 + I6 + I7 + I8 + I9;
    for (int it = gw; it < NITEMS; it += NGW) {
        int r = it;
        if (r < I0) { transpose_item(P.in[I_WIN] + (size_t)l * DM * NIN, NIN, DM, (bf16_t*)(ws + WS_WIN), 160, r, scr, lane); continue; } r -= I0;
        if (r < I1) { transpose_item(P.in[I_WIN] + (size_t)l * DM * NIN + 5128, NIN, DM, (bf16_t*)(ws + WS_WIN) + (size_t)5120 * DM, 96, r, scr, lane); continue; } r -= I1;
        if (r < I2) { transpose_item(P.in[I_WBR_RNN] + (size_t)l * DM * DM, DM, DM, (bf16_t*)(ws + WS_WBR_RNN), 32, r, scr, lane); continue; } r -= I2;
        if (r < I3) { transpose_item(P.in[I_WBR_DIFF] + (size_t)l * 512 * DM, DM, DM, (bf16_t*)(ws + WS_WBR_DIFF), 32, r, scr, lane); continue; } r -= I3;
        if (r < I4) { transpose_item(P.in[I_WBR_FOX] + (size_t)l * 512 * DM, DM, DM, (bf16_t*)(ws + WS_WBR_FOX), 32, r, scr, lane); continue; } r -= I4;
        if (r < I5) { transpose_item(P.in[I_WOUT] + (size_t)l * DM * DM, DM, DM, (bf16_t*)(ws + WS_WOUT), 32, r, scr, lane); continue; } r -= I5;
        if (r < I6) { transpose_item<true>(P.in[I_FUP] + (size_t)l * DM * DFF2, DFF2, DM, (bf16_t*)(ws + WS_WUP), 176, r, scr, lane); continue; } r -= I6;
        if (r < I7) { transpose_item(P.in[I_FDOWN] + (size_t)l * DFF * DM, DM, DFF, (bf16_t*)(ws + WS_WDOWN), 32, r, scr, lane); continue; } r -= I7;
        if (r < I8) { const int n = r >> 3; transpose_item(P.in[I_RGWR] + (size_t)l * 131072 + n * 16384, 128, 128, (bf16_t*)(ws + WS_RGR) + n * 16384, 4, r & 7, scr, lane); continue; } r -= I8;
        { const int n = r >> 3; transpose_item(P.in[I_RGWI] + (size_t)l * 131072 + n * 16384, 128, 128, (bf16_t*)(ws + WS_RGI) + n * 16384, 4, r & 7, scr, lane); }
    }
}

template <bool WITH_F>
__device__ __forceinline__ void rmsnorm_rows(const float* x, const float* g, bf16_t* hout, const Params& P, int l, LAS unsigned char* lds, int gw, int NGW, int lane) {
    LAS f32x4* wf = (LAS f32x4*)(lds + 73728);
    if (WITH_F) {
        const float* win = P.in[I_WIN] + (size_t)l * DM * NIN;
        for (int idx = threadIdx.x; idx < 8192; idx += blockDim.x) { const int k = idx >> 3, jj = idx & 7;
            const float v = g[k] * win[(size_t)k * NIN + 5120 + jj];
            const int ln = (k & 255) >> 2, e = k & 3, j = k >> 8, half = jj >> 2;
            ((LAS float*)wf)[((((j * 4 + e) * 2 + half) * 64 + ln) << 2) + (jj & 3)] = v; }
        __syncthreads();
    }
    f32x4 gv[4];
#pragma unroll
    for (int j = 0; j < 4; ++j) gv[j] = ((const f32x4*)g)[lane + 64 * j];
    const float bfv = WITH_F ? P.in[I_FOXB][l * 8 + (lane & 7)] : 0.f;
    for (int m = gw; m < MTOK; m += NGW) {
        const f32x4* xr = (const f32x4*)(x + (size_t)m * DM) + lane;
        f32x4 v[4]; float ss = 0.f;
#pragma unroll
        for (int j = 0; j < 4; ++j) { v[j] = xr[64 * j]; ss += (v[j].x * v[j].x + v[j].y * v[j].y) + (v[j].z * v[j].z + v[j].w * v[j].w); }
        const float rstd = fast_rsq(wave_sum(ss) * (1.0f / DM) + EPS);
        unsigned long long* o8 = (unsigned long long*)(hout + (size_t)m * DM) + lane;
#pragma unroll
        for (int j = 0; j < 4; ++j) { const f32x4 hv = v[j] * rstd * gv[j];
            o8[64 * j] = (unsigned long long)pk2(hv.x, hv.y) | ((unsigned long long)pk2(hv.z, hv.w) << 32); }
        if (WITH_F) {
            float a[8];
#pragma unroll
            for (int q = 0; q < 8; ++q) a[q] = 0.f;
#pragma unroll
            for (int j = 0; j < 4; ++j)
#pragma unroll
                for (int e = 0; e < 4; ++e) { const f32x4 w0 = wf[((j * 4 + e) * 2 + 0) * 64 + lane], w1 = wf[((j * 4 + e) * 2 + 1) * 64 + lane]; const float xv = v[j][e];
                    a[0] += xv * w0.x; a[1] += xv * w0.y; a[2] += xv * w0.z; a[3] += xv * w0.w; a[4] += xv * w1.x; a[5] += xv * w1.y; a[6] += xv * w1.z; a[7] += xv * w1.w; }
            float mine = 0.f;
#pragma unroll
            for (int q = 0; q < 8; ++q) { const float s = wave_sum(a[q]); if ((lane & 7) == q) mine = s; }
            if (lane < 8) { const float z = mine * rstd + bfv; const float lf = -(fmaxf(-z, 0.f) + log1p_small(fast_exp2(-fabsf(z) * LOG2E)));
                ((float*)(launder_ptr(P.ws) + WS_LOGF))[(size_t)m * 8 + lane] = lf; }
        }
    }
}

__device__ __forceinline__ void cumsum_logf(const Params& P, int b, int wid, int lane) {
    unsigned char* ws_ = launder_ptr(P.ws);
    const float* lf = (const float*)(ws_ + WS_LOGF) + (size_t)b * SEQ * 8 + wid;
    float* c = (float*)(ws_ + WS_C) + (size_t)b * SEQ * 8 + wid;
    float v[32]; float s = 0.f;
#pragma unroll
    for (int i = 0; i < 32; ++i) { s += lf[(size_t)(lane * 32 + i) * 8]; v[i] = s; }
    float inc = s;
#pragma unroll
    for (int o = 1; o < 64; o <<= 1) { const float t = __shfl_up(inc, o); if (lane >= o) inc += t; }
    const float excl = inc - s;
#pragma unroll
    for (int i = 0; i < 32; ++i) c[(size_t)(lane * 32 + i) * 8] = (excl + v[i]) * LOG2E;
}

__device__ __forceinline__ void rglru_unit(const Params& P, int l, int unit, LAS unsigned char* lds, bool dry = false) {
    const int tid = launder_tid(), lane = tid & 63, wid = __builtin_amdgcn_readfirstlane(tid >> 6), r32 = lane & 31, hi = lane >> 5;
    const int j = unit & 1, n = (unit >> 1) & 7, b = unit >> 4;
    unsigned char* ws_ = launder_ptr(P.ws);
    const int tb = wid & 3, cb = wid >> 2;
    const int dch = 64 * j + 32 * cb + r32, dglob = 128 * n + dch;
    bf16_t* proj = (bf16_t*)(ws_ + WS_P);
    LAS unsigned char* WB = lds + 104448;
    {
#pragma unroll
      for (int i = 0; i < 4; ++i) { const int idx = tid + 512 * i, gate = idx >> 10, rem = idx & 1023, d = rem >> 4, ch = rem & 15;
          const bf16_t* srcw = (const bf16_t*)(ws_ + (gate ? WS_RGI : WS_RGR)) + n * 16384 + (64 * j + d) * 128 + ch * 8;
          *(LAS u32x4*)(WB + (gate * 64 + d) * 272 + ch * 16) = *(const u32x4*)srcw; } }
    const float br = P.in[I_RGBR][l * DM + dglob], bi = P.in[I_RGBI][l * DM + dglob];
    const float ap_ = P.in[I_RGA][l * DM + dglob]; const float sp8 = 8.0f * (fmaxf(-ap_, 0.f) + log1p_small(fast_exp2(-fabsf(ap_) * LOG2E)));
    const int cc = tid & 15, rg = tid >> 4;
    float cw[4][8], cbias[8];
#pragma unroll
    for (int e = 0; e < 8; ++e) { cbias[e] = P.in[I_RCB][l * DM + 128 * n + 8 * cc + e];
#pragma unroll
        for (int k = 0; k < 4; ++k) cw[k][e] = P.in[I_RCW][(l * 4 + k) * DM + 128 * n + 8 * cc + e]; }
    LAS unsigned char* xc = lds;
    LAS float* Ab = (LAS float*)(lds + 34816);
    LAS float* Ub = (LAS float*)(lds + 67584);
    LAS f32x2* seg = (LAS f32x2*)(lds + 100352);
    float carry = 0.f;
    const size_t rowb = (size_t)b * SEQ;
    u32x4 xw[7];
#define RG_XLOAD(T0) do { _Pragma("unroll") for (int k = 0; k < 7; ++k) { const int t = (T0) + 4 * rg - 3 + k; xw[k] = (u32x4){0u, 0u, 0u, 0u}; \
        if (t >= 0) xw[k] = *(const u32x4*)(proj + O_XR + (rowb + t) * XP + 128 * n + 8 * cc); } } while (0)
    RG_XLOAD(0);
    for (int tile = 0; tile < SEQ / 128; ++tile) {
        const int t0 = tile * 128;
        {
            float xv[7][8];
#pragma unroll
            for (int k = 0; k < 7; ++k) { const u32x4 w = xw[k];
                xv[k][0] = bflo(w.x); xv[k][1] = bfhi(w.x); xv[k][2] = bflo(w.y); xv[k][3] = bfhi(w.y); xv[k][4] = bflo(w.z); xv[k][5] = bfhi(w.z); xv[k][6] = bflo(w.w); xv[k][7] = bfhi(w.w); }
#pragma unroll
            for (int i = 0; i < 4; ++i) { float o[8];
#pragma unroll
                for (int e = 0; e < 8; ++e) o[e] = cbias[e] + cw[0][e] * xv[i][e] + cw[1][e] * xv[i + 1][e] + cw[2][e] * xv[i + 2][e] + cw[3][e] * xv[i + 3][e];
                u32x4 w; w.x = pk2(o[0], o[1]); w.y = pk2(o[2], o[3]); w.z = pk2(o[4], o[5]); w.w = pk2(o[6], o[7]);
                *(LAS u32x4*)(xc + (4 * rg + i) * 272 + cc * 16) = w; }
        }
        if (tile + 1 < SEQ / 128) RG_XLOAD(t0 + 128);
        const int sc = lane, ss = wid;
        bf16_t* gp = proj + O_GR + (rowb + t0 + 16 * ss) * XP + 128 * n + 64 * j + sc;
        unsigned short gq[16];
#pragma unroll
        for (int k = 0; k < 16; ++k) gq[k] = gp[(size_t)k * XP];
        __syncthreads();
        f32x16 accr = {}, acci = {};
#pragma unroll
        for (int s = 0; s < 8; ++s) { const bf16x8 a = *(const LAS bf16x8*)(xc + (32 * tb + r32) * 272 + (16 * s + 8 * hi) * 2);
            const bf16x8 wr_ = *(const LAS bf16x8*)(WB + (32 * cb + r32) * 272 + (16 * s + 8 * hi) * 2), wi_ = *(const LAS bf16x8*)(WB + (64 + 32 * cb + r32) * 272 + (16 * s + 8 * hi) * 2);
            accr = __builtin_amdgcn_mfma_f32_32x32x16_bf16(a, wr_, accr, 0, 0, 0); acci = __builtin_amdgcn_mfma_f32_32x32x16_bf16(a, wi_, acci, 0, 0, 0); }
#pragma unroll
        for (int r = 0; r < 16; ++r) { const int tok = 32 * tb + crow(r, hi);
            const float rr = sigmoidf_(accr[r] + br), ii = sigmoidf_(acci[r] + bi);
            const float la = -rr * sp8; const float a = fast_exp2(la * LOG2E);
            const float x2 = 2.0f * la;
            const float em = -x2 * (1.0f + x2 * (0.5f + x2 * (0.16666667f + x2 * (0.041666668f + x2 * (0.0083333338f + x2 * 0.0013888889f)))));
            const float mult = __builtin_sqrtf(fmaxf(em, 0.f));
            const float xcv = bf2f(*(const LAS unsigned short*)(xc + tok * 272 + dch * 2));
            Ab[tok * 64 + 32 * cb + r32] = a; Ub[tok * 64 + 32 * cb + r32] = mult * ii * xcv; }
        __syncthreads();
        { const int c = sc, s = ss;
          float As = 1.f, Hs = 0.f;
#pragma unroll
          for (int k = 0; k < 16; ++k) { const float a = Ab[(16 * s + k) * 64 + c], u = Ub[(16 * s + k) * 64 + c]; Hs = a * Hs + u; As *= a; }
          seg[s * 64 + c] = (f32x2){As, Hs};
          __syncthreads();
          float hin = carry, hn = carry;
#pragma unroll
          for (int s2 = 0; s2 < 8; ++s2) { if (s2 == s) hin = hn; const f32x2 sg = seg[s2 * 64 + c]; hn = sg.x * hn + sg.y; }
          carry = hn;
          float h = hin;
#pragma unroll
          for (int k = 0; k < 16; ++k) { const float a = Ab[(16 * s + k) * 64 + c], u = Ub[(16 * s + k) * 64 + c]; h = a * h + u;
              const float gg = bf2f(gq[k]); gp[(size_t)k * XP] = (bf16_t)f2bf(dry ? gg : gg * h); }
        }
    }
#undef RG_XLOAD
    __syncthreads();
}

__device__ __forceinline__ float half_max(float v) { auto rr = __builtin_amdgcn_permlane32_swap(__float_as_uint(v), __float_as_uint(v), false, false); return fmaxf(__uint_as_float(rr[0]), __uint_as_float(rr[1])); }
__device__ __forceinline__ float half_sum(float v) { auto rr = __builtin_amdgcn_permlane32_swap(__float_as_uint(v), __float_as_uint(v), false, false); return __uint_as_float(rr[0]) + __uint_as_float(rr[1]); }

__device__ __forceinline__ void attn_qk(f32x16& p0, f32x16& p1, const LAS unsigned char* Kt, int kstride, const bf16x8 (&qf)[4], int r32, int hi) {
#pragma unroll
    for (int d0 = 0; d0 < 4; ++d0) {
        const bf16x8 k0 = *(const LAS bf16x8*)(Kt + r32 * kstride + d0 * 32 + hi * 16);
        const bf16x8 k1 = *(const LAS bf16x8*)(Kt + (r32 + 32) * kstride + d0 * 32 + hi * 16);
        p0 = __builtin_amdgcn_mfma_f32_32x32x16_bf16(k0, qf[d0], p0, 0, 0, 0);
        p1 = __builtin_amdgcn_mfma_f32_32x32x16_bf16(k1, qf[d0], p1, 0, 0, 0);
    }
}

template <int NDT, int VSTR>
__device__ __forceinline__ void attn_sm_pv(f32x16& p0, f32x16& p1, f32x16& n0, f32x16& n1, bool has_next, const LAS unsigned char* Vt,
                                           f32x16 (&o)[NDT], float& mref, float& lrun, bool first, bool domask, int qrel, LAS float* wsf, int r32, int hi) {
    if (domask) {
#pragma unroll
        for (int r = 0; r < 16; ++r) { const int kv = crow(r, hi); if (kv > qrel) p0[r] = -INFINITY; if (kv + 32 > qrel) p1[r] = -INFINITY; }
    }
    float ra = fmaxf(fmaxf(p0[0], p0[1]), p1[0]), rb = fmaxf(fmaxf(p0[2], p0[3]), p1[1]);
    ra = fmaxf(fmaxf(ra, p1[2]), p1[3]);
#pragma unroll
    for (int r = 4; r < 16; r += 4) { ra = fmaxf(fmaxf(ra, p0[r]), p0[r + 1]); rb = fmaxf(fmaxf(rb, p0[r + 2]), p0[r + 3]); ra = fmaxf(fmaxf(ra, p1[r]), p1[r + 1]); rb = fmaxf(fmaxf(rb, p1[r + 2]), p1[r + 3]); }
    const float rm = half_max(fmaxf(ra, rb));
    if (first || __any(rm > 8.0f)) {
        const float dl = first ? rm : fmaxf(rm, 0.f);
        mref += dl;
#pragma unroll
        for (int r = 0; r < 16; ++r) { p0[r] -= dl; p1[r] -= dl; }
        if (has_next) {
#pragma unroll
            for (int r = 0; r < 16; ++r) { n0[r] -= dl; n1[r] -= dl; } }
        if (!first) {
            const float alpha = fast_exp2(-dl);
            lrun *= alpha;
            if (hi == 0) wsf[r32] = alpha;
            asm volatile("s_waitcnt lgkmcnt(0)" ::: "memory");
#pragma unroll
            for (int jj = 0; jj < 4; ++jj) { const f32x4 al = *(const LAS f32x4*)(wsf + 8 * jj + 4 * hi);
#pragma unroll
                for (int d = 0; d < NDT; ++d) { o[d][4 * jj + 0] *= al.x; o[d][4 * jj + 1] *= al.y; o[d][4 * jj + 2] *= al.z; o[d][4 * jj + 3] *= al.w; } }
            asm volatile("s_waitcnt lgkmcnt(0)" ::: "memory");
        }
    }
    constexpr int PRE = (NDT == 2) ? 4 : 1;
    const int lane_ = hi * 32 + r32;
    const LAS unsigned char* vb = Vt + (4 * hi + ((lane_ & 15) >> 2)) * VSTR + (16 * ((lane_ >> 4) & 1) + 4 * (lane_ & 3)) * 2;
#define VFRAG(s, d) ({ const s16x4 lo_ = __builtin_bit_cast(s16x4, __builtin_amdgcn_ds_read_tr16_b64_v4i16((LAS s16x4*)(vb + (16 * (s)) * VSTR + 64 * (d)))); \
                       const s16x4 hh_ = __builtin_bit_cast(s16x4, __builtin_amdgcn_ds_read_tr16_b64_v4i16((LAS s16x4*)(vb + (16 * (s) + 8) * VSTR + 64 * (d)))); \
                       (bf16x8){lo_[0], lo_[1], lo_[2], lo_[3], hh_[0], hh_[1], hh_[2], hh_[3]}; })
    bf16x8 vpre[PRE][NDT];
#pragma unroll
    for (int s = 0; s < PRE; ++s)
#pragma unroll
        for (int d = 0; d < NDT; ++d) vpre[s][d] = VFRAG(s, d);
    float rs0 = 0.f, rs1 = 0.f;
#pragma unroll
    for (int r = 0; r < 16; ++r) { p0[r] = fast_exp2(p0[r]); p1[r] = fast_exp2(p1[r]); rs0 += p0[r]; rs1 += p1[r]; }
    lrun += rs0 + rs1;
    bf16x8 pa[4];
#pragma unroll
    for (int s = 0; s < 2; ++s) {
        u32x4 w0, w1;
        w0.x = cvt_pk_bf16(p0[8 * s + 0], p0[8 * s + 1]); w0.y = cvt_pk_bf16(p0[8 * s + 2], p0[8 * s + 3]); w0.z = cvt_pk_bf16(p0[8 * s + 4], p0[8 * s + 5]); w0.w = cvt_pk_bf16(p0[8 * s + 6], p0[8 * s + 7]);
        w1.x = cvt_pk_bf16(p1[8 * s + 0], p1[8 * s + 1]); w1.y = cvt_pk_bf16(p1[8 * s + 2], p1[8 * s + 3]); w1.z = cvt_pk_bf16(p1[8 * s + 4], p1[8 * s + 5]); w1.w = cvt_pk_bf16(p1[8 * s + 6], p1[8 * s + 7]);
        pa[s] = __builtin_bit_cast(bf16x8, w0); pa[2 + s] = __builtin_bit_cast(bf16x8, w1);
    }
#pragma unroll
    for (int s = 0; s < 4; ++s) {
        bf16x8 vw[NDT];
#pragma unroll
        for (int d = 0; d < NDT; ++d) { if (s < PRE) vw[d] = vpre[s < PRE ? s : 0][d]; else vw[d] = VFRAG(s, d); }
#pragma unroll
        for (int d = 0; d < NDT; ++d) o[d] = __builtin_amdgcn_mfma_f32_32x32x16_bf16(pa[s], vw[d], o[d], 0, 0, 0);
    }
#undef VFRAG
}

#define SBAR_() __builtin_amdgcn_sched_barrier(0)
__device__ __forceinline__ float rowmax32(const f32x16& a, const f32x16& b) {
    float ra = fmaxf(fmaxf(a[0], a[1]), b[0]), rb = fmaxf(fmaxf(a[2], a[3]), b[1]);
    ra = fmaxf(fmaxf(ra, b[2]), b[3]);
#pragma unroll
    for (int r = 4; r < 16; r += 4) { ra = fmaxf(fmaxf(ra, a[r]), a[r + 1]); rb = fmaxf(fmaxf(rb, a[r + 2]), a[r + 3]); ra = fmaxf(fmaxf(ra, b[r]), b[r + 1]); rb = fmaxf(fmaxf(rb, b[r + 2]), b[r + 3]); }
    return half_max(fmaxf(ra, rb));
}
__device__ __forceinline__ void fox_steady_step(f32x16& s0, f32x16& s1, f32x16& n0, f32x16& n1, const LAS unsigned char* kb, int coff, const LAS unsigned char* Vt,
                                                const bf16x8 (&qf)[4], f32x16 (&o)[2], float& mref, float& lrun, float cq, LAS float* wsf, int r32, int hi, float& rmc) {
    const float rm = rmc;
    if (__any(rm > 8.0f)) {
        const float dl = fmaxf(rm, 0.f);
        mref += dl;
#pragma unroll
        for (int r = 0; r < 16; ++r) { s0[r] -= dl; s1[r] -= dl; }
        const float alpha = fast_exp2(-dl);
        lrun *= alpha;
        if (hi == 0) wsf[r32] = alpha;
        asm volatile("s_waitcnt lgkmcnt(0)" ::: "memory");
#pragma unroll
        for (int jj = 0; jj < 4; ++jj) { const f32x4 al = *(const LAS f32x4*)(wsf + 8 * jj + 4 * hi);
#pragma unroll
            for (int d = 0; d < 2; ++d) { o[d][4 * jj + 0] *= al.x; o[d][4 * jj + 1] *= al.y; o[d][4 * jj + 2] *= al.z; o[d][4 * jj + 3] *= al.w; } }
        asm volatile("s_waitcnt lgkmcnt(0)" ::: "memory");
    }
    bf16x8 kf[8]; f32x4 ck4[8]; bf16x8 vf[4][2];
#pragma unroll
    for (int d0 = 0; d0 < 4; ++d0) { kf[2 * d0] = *(const LAS bf16x8*)(kb + r32 * 144 + d0 * 32 + hi * 16); kf[2 * d0 + 1] = *(const LAS bf16x8*)(kb + (r32 + 32) * 144 + d0 * 32 + hi * 16); }
#pragma unroll
    for (int jj = 0; jj < 4; ++jj) { ck4[jj] = *(const LAS f32x4*)(kb + coff + (8 * jj + 4 * hi) * 4); ck4[4 + jj] = *(const LAS f32x4*)(kb + coff + (32 + 8 * jj + 4 * hi) * 4); }
    { const int lane_ = hi * 32 + r32;
      const LAS unsigned char* vb = Vt + (4 * hi + ((lane_ & 15) >> 2)) * 192 + (16 * ((lane_ >> 4) & 1) + 4 * (lane_ & 3)) * 2;
#pragma unroll
      for (int s = 0; s < 4; ++s)
#pragma unroll
          for (int d = 0; d < 2; ++d) {
              const s16x4 lo_ = __builtin_bit_cast(s16x4, __builtin_amdgcn_ds_read_tr16_b64_v4i16((LAS s16x4*)(vb + (16 * s) * 192 + 64 * d)));
              const s16x4 hh_ = __builtin_bit_cast(s16x4, __builtin_amdgcn_ds_read_tr16_b64_v4i16((LAS s16x4*)(vb + (16 * s + 8) * 192 + 64 * d)));
              vf[s][d] = (bf16x8){lo_[0], lo_[1], lo_[2], lo_[3], hh_[0], hh_[1], hh_[2], hh_[3]}; } }
    { const float cqm = cq - mref;
#pragma unroll
      for (int jj = 0; jj < 4; ++jj)
#pragma unroll
          for (int e = 0; e < 4; ++e) { n0[4 * jj + e] = cqm - ck4[jj][e]; n1[4 * jj + e] = cqm - ck4[4 + jj][e]; } }
    SBAR_();
    float rs = 0.f; u32x4 w0, w1, w2, w3;
#define EXPN_(P, B, N) do { _Pragma("unroll") for (int e_ = 0; e_ < (N); ++e_) { P[(B) + e_] = fast_exp2(P[(B) + e_]); rs += P[(B) + e_]; } } while (0)
    n0 = __builtin_amdgcn_mfma_f32_32x32x16_bf16(kf[0], qf[0], n0, 0, 0, 0); EXPN_(s0, 0, 3); SBAR_();
    n1 = __builtin_amdgcn_mfma_f32_32x32x16_bf16(kf[1], qf[0], n1, 0, 0, 0); EXPN_(s0, 3, 3); w0.x = cvt_pk_bf16(s0[0], s0[1]); w0.y = cvt_pk_bf16(s0[2], s0[3]); SBAR_();
    n0 = __builtin_amdgcn_mfma_f32_32x32x16_bf16(kf[2], qf[1], n0, 0, 0, 0); EXPN_(s0, 6, 3); w0.z = cvt_pk_bf16(s0[4], s0[5]); w0.w = cvt_pk_bf16(s0[6], s0[7]); SBAR_();
    n1 = __builtin_amdgcn_mfma_f32_32x32x16_bf16(kf[3], qf[1], n1, 0, 0, 0); EXPN_(s0, 9, 3); w1.x = cvt_pk_bf16(s0[8], s0[9]); w1.y = cvt_pk_bf16(s0[10], s0[11]); SBAR_();
    n0 = __builtin_amdgcn_mfma_f32_32x32x16_bf16(kf[4], qf[2], n0, 0, 0, 0); EXPN_(s0, 12, 4); w1.z = cvt_pk_bf16(s0[12], s0[13]); w1.w = cvt_pk_bf16(s0[14], s0[15]); SBAR_();
    n1 = __builtin_amdgcn_mfma_f32_32x32x16_bf16(kf[5], qf[2], n1, 0, 0, 0); EXPN_(s1, 0, 3); SBAR_();
    n0 = __builtin_amdgcn_mfma_f32_32x32x16_bf16(kf[6], qf[3], n0, 0, 0, 0); EXPN_(s1, 3, 3); w2.x = cvt_pk_bf16(s1[0], s1[1]); w2.y = cvt_pk_bf16(s1[2], s1[3]); SBAR_();
    n1 = __builtin_amdgcn_mfma_f32_32x32x16_bf16(kf[7], qf[3], n1, 0, 0, 0); EXPN_(s1, 6, 2); w2.z = cvt_pk_bf16(s1[4], s1[5]); w2.w = cvt_pk_bf16(s1[6], s1[7]); SBAR_();
    const bf16x8 pa0 = __builtin_bit_cast(bf16x8, w0), pa1 = __builtin_bit_cast(bf16x8, w1), pa2 = __builtin_bit_cast(bf16x8, w2);
    float ra = fmaxf(fmaxf(n0[0], n0[1]), n1[0]), rb = fmaxf(fmaxf(n0[2], n0[3]), n1[1]);
    o[0] = __builtin_amdgcn_mfma_f32_32x32x16_bf16(pa0, vf[0][0], o[0], 0, 0, 0); EXPN_(s1, 8, 2); ra = fmaxf(fmaxf(ra, n1[2]), n1[3]); SBAR_();
    o[1] = __builtin_amdgcn_mfma_f32_32x32x16_bf16(pa0, vf[0][1], o[1], 0, 0, 0); EXPN_(s1, 10, 2); w3.x = cvt_pk_bf16(s1[8], s1[9]); rb = fmaxf(fmaxf(rb, n0[4]), n0[5]); SBAR_();
    o[0] = __builtin_amdgcn_mfma_f32_32x32x16_bf16(pa1, vf[1][0], o[0], 0, 0, 0); EXPN_(s1, 12, 2); w3.y = cvt_pk_bf16(s1[10], s1[11]); ra = fmaxf(fmaxf(ra, n0[6]), n0[7]); SBAR_();
    o[1] = __builtin_amdgcn_mfma_f32_32x32x16_bf16(pa1, vf[1][1], o[1], 0, 0, 0); EXPN_(s1, 14, 2); w3.z = cvt_pk_bf16(s1[12], s1[13]); rb = fmaxf(fmaxf(rb, n1[4]), n1[5]); SBAR_();
    o[0] = __builtin_amdgcn_mfma_f32_32x32x16_bf16(pa2, vf[2][0], o[0], 0, 0, 0); w3.w = cvt_pk_bf16(s1[14], s1[15]); ra = fmaxf(fmaxf(ra, n1[6]), n1[7]); rb = fmaxf(fmaxf(rb, n0[8]), n0[9]); SBAR_();
    o[1] = __builtin_amdgcn_mfma_f32_32x32x16_bf16(pa2, vf[2][1], o[1], 0, 0, 0); ra = fmaxf(fmaxf(ra, n0[10]), n0[11]); rb = fmaxf(fmaxf(rb, n1[8]), n1[9]); ra = fmaxf(fmaxf(ra, n1[10]), n1[11]); rb = fmaxf(fmaxf(rb, n0[12]), n0[13]); SBAR_();
    const bf16x8 pa3 = __builtin_bit_cast(bf16x8, w3);
    lrun += rs;
    o[0] = __builtin_amdgcn_mfma_f32_32x32x16_bf16(pa3, vf[3][0], o[0], 0, 0, 0); ra = fmaxf(fmaxf(ra, n0[14]), n0[15]); rb = fmaxf(fmaxf(rb, n1[12]), n1[13]); ra = fmaxf(fmaxf(ra, n1[14]), n1[15]); SBAR_();
    o[1] = __builtin_amdgcn_mfma_f32_32x32x16_bf16(pa3, vf[3][1], o[1], 0, 0, 0);
#undef EXPN_
    rmc = half_max(fmaxf(ra, rb));
}

__device__ __forceinline__ void fox_unit(const Params& P, int b, int h, int qb, LAS unsigned char* lds, bool dry = false) {
    unsigned char* ws_ = launder_ptr(P.ws);
    const int tid = launder_tid(), lane = tid & 63, wid = __builtin_amdgcn_readfirstlane(tid >> 6), r32 = lane & 31, hi = lane >> 5;
    bf16_t* proj = (bf16_t*)(ws_ + WS_P);
    const float* cbuf = (const float*)(ws_ + WS_C);
    const size_t rowb = (size_t)b * SEQ; const int q0 = qb * 256;
    constexpr int BUFB = 21760, KOFF = 0, VOFF = 9216, COFF = 21504, FVS = 192;
    LAS float* wsf = (LAS float*)(lds + 2 * BUFB) + wid * 64;
    bf16x8 qf[4];
    { const bf16_t* Qw = proj + O_FQ + (rowb + q0 + wid * 32 + r32) * QP + h * 64;
#pragma unroll
      for (int d0 = 0; d0 < 4; ++d0) qf[d0] = *(const bf16x8*)(Qw + d0 * 16 + hi * 8); }
    const float cq = cbuf[(rowb + q0 + wid * 32 + r32) * 8 + h];
    f32x16 o[2]; o[0] = f32x16{}; o[1] = f32x16{};
    float mref = 0.f, lrun = 0.f;
    const int NT = 4 * (qb + 1);
    const int srow = tid >> 3, sch = tid & 7;
    u32x4 kreg, vreg; float creg = 0.f;
    const bf16_t* sbase = proj + (rowb + srow) * QP + h * 64 + sch * 8;
#define FOX_GLOADK(t) do { kreg = *(const u32x4*)(sbase + O_FK + (size_t)(64 * (t)) * QP); if (tid < 64) creg = cbuf[(rowb + 64 * (t) + tid) * 8 + h]; } while (0)
#define FOX_GLOADV(t) do { vreg = *(const u32x4*)(sbase + O_FV + (size_t)(64 * (t)) * QP); } while (0)
#define FOX_LSTOREK(buf) do { LAS unsigned char* bb_ = lds + (buf) * BUFB; *(LAS u32x4*)(bb_ + KOFF + srow * 144 + sch * 16) = kreg; if (tid < 64) *(LAS float*)(bb_ + COFF + tid * 4) = creg; } while (0)
#define FOX_LSTOREV(buf) (*(LAS u32x4*)(lds + (buf) * BUFB + VOFF + srow * FVS + sch * 16) = vreg)
#define FOX_INIT(P0, P1, buf) do { const LAS unsigned char* bb_ = lds + (buf) * BUFB; const float cqm = cq - mref; \
        _Pragma("unroll") for (int jj = 0; jj < 4; ++jj) { const f32x4 c0 = *(const LAS f32x4*)(bb_ + COFF + (8 * jj + 4 * hi) * 4), c1 = *(const LAS f32x4*)(bb_ + COFF + (32 + 8 * jj + 4 * hi) * 4); \
            _Pragma("unroll") for (int e = 0; e < 4; ++e) { P0[4 * jj + e] = cqm - c0[e]; P1[4 * jj + e] = cqm - c1[e]; } } } while (0)
    FOX_GLOADK(0); FOX_GLOADV(0); FOX_LSTOREK(0); FOX_LSTOREV(0);
    FOX_GLOADK(1); FOX_LSTOREK(1);
    __syncthreads();
    f32x16 s0, s1, n0 = {}, n1 = {};
    FOX_INIT(s0, s1, 0); attn_qk(s0, s1, lds + KOFF, 144, qf, r32, hi);
#define FOX_ITER(t, S0, S1, N0, N1) do { \
        if ((t) + 2 < NT) FOX_GLOADK((t) + 2); \
        if ((t) + 1 < NT) FOX_GLOADV((t) + 1); \
        const int jb = (t) - (NT - 4); \
        const bool active = (jb < 0) || (jb <= (wid >> 1)); \
        const bool act_next = ((t) + 1 < NT) && ((jb + 1 < 0) || (jb + 1 <= (wid >> 1))); \
        if (act_next) { FOX_INIT(N0, N1, ((t) + 1) & 1); attn_qk(N0, N1, lds + (((t) + 1) & 1) * BUFB + KOFF, 144, qf, r32, hi); } \
        if (active) { const bool domask = (jb >= 0) && (64 * jb + 63 > 32 * wid); \
            attn_sm_pv<2, 192>(S0, S1, N0, N1, act_next, lds + ((t) & 1) * BUFB + VOFF, o, mref, lrun, (t) == 0, domask, q0 + wid * 32 + r32 - 64 * (t), wsf, r32, hi); } \
        if ((t) + 2 < NT) FOX_LSTOREK((t) & 1); \
        if ((t) + 1 < NT) FOX_LSTOREV(((t) + 1) & 1); \
        __syncthreads(); } while (0)
#define FOX_STEADY(t, S0, S1, N0, N1) do { \
        FOX_GLOADK((t) + 2); FOX_GLOADV((t) + 1); \
        fox_steady_step(S0, S1, N0, N1, lds + (((t) + 1) & 1) * BUFB + KOFF, COFF - KOFF, lds + ((t) & 1) * BUFB + VOFF, qf, o, mref, lrun, cq, wsf, r32, hi, rmc); \
        FOX_LSTOREK((t) & 1); FOX_LSTOREV(((t) + 1) & 1); \
        __syncthreads(); } while (0)
    FOX_ITER(0, s0, s1, n0, n1);
    int t = 1;
    float rmc = 0.f;
    if (t + 1 <= NT - 6) rmc = rowmax32(n0, n1);
    for (; t + 1 <= NT - 6; t += 2) { FOX_STEADY(t, n0, n1, s0, s1); FOX_STEADY(t + 1, s0, s1, n0, n1); }
    for (; t + 1 < NT; t += 2) { FOX_ITER(t, n0, n1, s0, s1); FOX_ITER(t + 1, s0, s1, n0, n1); }
    FOX_ITER(NT - 1, n0, n1, s0, s1);
#undef FOX_STEADY
#undef FOX_ITER
#undef FOX_GLOADK
#undef FOX_GLOADV
#undef FOX_LSTOREK
#undef FOX_LSTOREV
#undef FOX_INIT
    const float lt = half_sum(lrun);
    if (hi == 0) wsf[r32] = fast_rcp(lt);
    asm volatile("s_waitcnt lgkmcnt(0)" ::: "memory");
    bf16_t* Ow = proj + O_FQ + (rowb + q0 + wid * 32) * QP + h * 64;
#pragma unroll
    for (int r = 0; r < 16; ++r) { const int q = crow(r, hi); const float il = wsf[q];
#pragma unroll
        for (int d = 0; d < 2; ++d) if (!dry || o[d][r] == 1.2345e30f) Ow[(size_t)q * QP + 32 * d + r32] = (bf16_t)f2bf(o[d][r] * il); }
    __syncthreads();
}

__device__ __forceinline__ void diff_steady_step(f32x16& s0, f32x16& s1, f32x16& n0, f32x16& n1, const LAS unsigned char* kb, const LAS unsigned char* Vt, const LAS unsigned char* qlds,
                                                 f32x16 (&o)[4], float& mref, float& lrun, float b31, LAS float* wsf, int r32, int hi, float& rmc, const bf16_t* vsrc, size_t vstep, u32x4 (&vreg)[2]) {
    const float rm = rmc;
    if (__any(rm > 8.0f)) {
        const float dl = fmaxf(rm, 0.f);
        mref += dl;
#pragma unroll
        for (int r = 0; r < 16; ++r) { s0[r] -= dl; s1[r] -= dl; }
        const float alpha = fast_exp2(-dl);
        lrun *= alpha;
        if (hi == 0) wsf[r32] = alpha;
        asm volatile("s_waitcnt lgkmcnt(0)" ::: "memory");
#pragma unroll
        for (int jj = 0; jj < 4; ++jj) { const f32x4 al = *(const LAS f32x4*)(wsf + 8 * jj + 4 * hi);
#pragma unroll
            for (int d = 0; d < 4; ++d) { o[d][4 * jj + 0] *= al.x; o[d][4 * jj + 1] *= al.y; o[d][4 * jj + 2] *= al.z; o[d][4 * jj + 3] *= al.w; } }
        asm volatile("s_waitcnt lgkmcnt(0)" ::: "memory");
    }
    const int lane_ = hi * 32 + r32;
    const LAS unsigned char* vb = Vt + (4 * hi + ((lane_ & 15) >> 2)) * 320 + (16 * ((lane_ >> 4) & 1) + 4 * (lane_ & 3)) * 2;
#define DVF_(s, d) ({ const s16x4 lo_ = __builtin_bit_cast(s16x4, __builtin_amdgcn_ds_read_tr16_b64_v4i16((LAS s16x4*)(vb + (16 * (s)) * 320 + 64 * (d)))); \
                      const s16x4 hh_ = __builtin_bit_cast(s16x4, __builtin_amdgcn_ds_read_tr16_b64_v4i16((LAS s16x4*)(vb + (16 * (s) + 8) * 320 + 64 * (d)))); \
                      (bf16x8){lo_[0], lo_[1], lo_[2], lo_[3], hh_[0], hh_[1], hh_[2], hh_[3]}; })
    bf16x8 ka[3], kc[3], va[4];
#define DKF_(dst, d0) do { dst[0] = *(const LAS bf16x8*)(kb + r32 * 272 + (d0) * 32 + hi * 16); dst[1] = *(const LAS bf16x8*)(kb + (r32 + 32) * 272 + (d0) * 32 + hi * 16); dst[2] = *(const LAS bf16x8*)(qlds + (d0) * 32); } while (0)
    DKF_(ka, 0); DKF_(kc, 1);
    { const float v_ = b31 - mref;
#pragma unroll
      for (int r = 0; r < 16; ++r) { n0[r] = v_; n1[r] = v_; } }
    SBAR_();
    float rs = 0.f; u32x4 w0, w1, w2, w3;
#define EXPN_(P, B, N) do { _Pragma("unroll") for (int e_ = 0; e_ < (N); ++e_) { P[(B) + e_] = fast_exp2(P[(B) + e_]); rs += P[(B) + e_]; } } while (0)
#define MF_(dst, a_, b_) dst = __builtin_amdgcn_mfma_f32_32x32x16_bf16(a_, b_, dst, 0, 0, 0)
    MF_(n0, ka[0], ka[2]); EXPN_(s0, 0, 2); SBAR_();
    MF_(n1, ka[1], ka[2]); DKF_(ka, 2); EXPN_(s0, 2, 2); w0.x = cvt_pk_bf16(s0[0], s0[1]); SBAR_();
    MF_(n0, kc[0], kc[2]); EXPN_(s0, 4, 2); w0.y = cvt_pk_bf16(s0[2], s0[3]); SBAR_();
    MF_(n1, kc[1], kc[2]); DKF_(kc, 3); EXPN_(s0, 6, 2); w0.z = cvt_pk_bf16(s0[4], s0[5]); SBAR_();
    MF_(n0, ka[0], ka[2]); EXPN_(s0, 8, 2); w0.w = cvt_pk_bf16(s0[6], s0[7]); SBAR_();
    MF_(n1, ka[1], ka[2]); EXPN_(s0, 10, 2); w1.x = cvt_pk_bf16(s0[8], s0[9]); SBAR_();
    MF_(n0, kc[0], kc[2]); EXPN_(s0, 12, 2); w1.y = cvt_pk_bf16(s0[10], s0[11]); SBAR_();
#pragma unroll
    for (int d = 0; d < 4; ++d) va[d] = DVF_(0, d);
    MF_(n1, kc[1], kc[2]); EXPN_(s0, 14, 2); w1.z = cvt_pk_bf16(s0[12], s0[13]); w1.w = cvt_pk_bf16(s0[14], s0[15]); SBAR_();
    vreg[0] = *(const u32x4*)vsrc; vreg[1] = *(const u32x4*)(vsrc + vstep);
    const bf16x8 pa0 = __builtin_bit_cast(bf16x8, w0), pa1 = __builtin_bit_cast(bf16x8, w1);
    SBAR_();
    MF_(o[0], pa0, va[0]); EXPN_(s1, 0, 2); SBAR_();
    MF_(o[1], pa0, va[1]); va[0] = DVF_(1, 0); va[1] = DVF_(1, 1); EXPN_(s1, 2, 2); w2.x = cvt_pk_bf16(s1[0], s1[1]); SBAR_();
    MF_(o[2], pa0, va[2]); va[2] = DVF_(1, 2); EXPN_(s1, 4, 2); w2.y = cvt_pk_bf16(s1[2], s1[3]); SBAR_();
    MF_(o[3], pa0, va[3]); va[3] = DVF_(1, 3); EXPN_(s1, 6, 2); w2.z = cvt_pk_bf16(s1[4], s1[5]); w2.w = cvt_pk_bf16(s1[6], s1[7]); SBAR_();
    MF_(o[0], pa1, va[0]); EXPN_(s1, 8, 2); SBAR_();
    MF_(o[1], pa1, va[1]); va[0] = DVF_(2, 0); va[1] = DVF_(2, 1); EXPN_(s1, 10, 2); w3.x = cvt_pk_bf16(s1[8], s1[9]); SBAR_();
    MF_(o[2], pa1, va[2]); va[2] = DVF_(2, 2); EXPN_(s1, 12, 2); w3.y = cvt_pk_bf16(s1[10], s1[11]); SBAR_();
    MF_(o[3], pa1, va[3]); va[3] = DVF_(2, 3); EXPN_(s1, 14, 2); w3.z = cvt_pk_bf16(s1[12], s1[13]); w3.w = cvt_pk_bf16(s1[14], s1[15]); SBAR_();
    lrun += rs;
    const bf16x8 pa2 = __builtin_bit_cast(bf16x8, w2), pa3 = __builtin_bit_cast(bf16x8, w3);
    float ra = fmaxf(fmaxf(n0[0], n0[1]), n1[0]), rb = fmaxf(fmaxf(n0[2], n0[3]), n1[1]);
    MF_(o[0], pa2, va[0]); ra = fmaxf(fmaxf(ra, n1[2]), n1[3]); rb = fmaxf(fmaxf(rb, n0[4]), n0[5]); SBAR_();
    MF_(o[1], pa2, va[1]); va[0] = DVF_(3, 0); va[1] = DVF_(3, 1); ra = fmaxf(fmaxf(ra, n0[6]), n0[7]); rb = fmaxf(fmaxf(rb, n1[4]), n1[5]); SBAR_();
    MF_(o[2], pa2, va[2]); va[2] = DVF_(3, 2); ra = fmaxf(fmaxf(ra, n1[6]), n1[7]); rb = fmaxf(fmaxf(rb, n0[8]), n0[9]); SBAR_();
    MF_(o[3], pa2, va[3]); va[3] = DVF_(3, 3); ra = fmaxf(fmaxf(ra, n0[10]), n0[11]); rb = fmaxf(fmaxf(rb, n1[8]), n1[9]); SBAR_();
    MF_(o[0], pa3, va[0]); ra = fmaxf(fmaxf(ra, n1[10]), n1[11]); rb = fmaxf(fmaxf(rb, n0[12]), n0[13]); SBAR_();
    MF_(o[1], pa3, va[1]); ra = fmaxf(fmaxf(ra, n0[14]), n0[15]); rb = fmaxf(fmaxf(rb, n1[12]), n1[13]); SBAR_();
    MF_(o[2], pa3, va[2]); ra = fmaxf(fmaxf(ra, n1[14]), n1[15]); SBAR_();
    MF_(o[3], pa3, va[3]);
#undef EXPN_
#undef MF_
#undef DVF_
#undef DKF_
    rmc = half_max(fmaxf(ra, rb));
}

__device__ __forceinline__ void diff_unit(const Params& P, int l, int b, int h, int qb, float lam, float lam_init, LAS unsigned char* lds, bool dry = false) {
    unsigned char* ws_ = launder_ptr(P.ws);
    const int tid = launder_tid(), lane = tid & 63, wid = __builtin_amdgcn_readfirstlane(tid >> 6), r32 = lane & 31, hi = lane >> 5;
    const int map = wid >> 2, wq = wid & 3;
    bf16_t* proj = (bf16_t*)(ws_ + WS_P);
    const size_t rowb = (size_t)b * SEQ; const int q0 = qb * 128;
    constexpr int BUFB = 37888, KOFF = 0, VOFF = 17408, DVS = 320;
    LAS float* wsf = (LAS float*)(lds + 2 * BUFB) + wid * 64;
    LAS float* bt = (LAS float*)(lds + 77824);
    LAS float* xch = (LAS float*)(lds + 79872);
    if (tid < 128) bt[tid] = P.in[I_REL][T5_BUCKET[tid] * 4 + h] * LOG2E;
    LAS unsigned char* qlds = lds + 79872 + wid * 4608 + r32 * 144 + hi * 16;
    { const bf16_t* Qw = proj + O_DQ + (rowb + q0 + wq * 32 + r32) * QP + h * 128 + map * 64;
#pragma unroll
      for (int d0 = 0; d0 < 4; ++d0) *(LAS bf16x8*)(qlds + d0 * 32) = *(const bf16x8*)(Qw + d0 * 16 + hi * 8); }
#define DIFF_QK(P0, P1, kt) do { bf16x8 qf[4]; _Pragma("unroll") for (int d0 = 0; d0 < 4; ++d0) qf[d0] = *(const LAS bf16x8*)(qlds + d0 * 32); attn_qk(P0, P1, kt, 272, qf, r32, hi); } while (0)
    f32x16 o[4];
#pragma unroll
    for (int d = 0; d < 4; ++d) o[d] = f32x16{};
    float mref = 0.f, lrun = 0.f;
    const int NT = 2 * (qb + 1);
    u32x4 kreg[2], vreg[2];
    const int srow = tid >> 4, sch = tid & 15;
    const bf16_t* sbase = proj + (rowb + srow) * QP + h * 128 + sch * 8;
#define DIFF_GLOADK(t) do { _Pragma("unroll") for (int i = 0; i < 2; ++i) kreg[i] = *(const u32x4*)(sbase + O_DK + (size_t)(64 * (t) + 32 * i) * QP); } while (0)
#define DIFF_GLOADV(t) do { _Pragma("unroll") for (int i = 0; i < 2; ++i) vreg[i] = *(const u32x4*)(sbase + O_DV + (size_t)(64 * (t) + 32 * i) * QP); } while (0)
#define DIFF_LSTOREK(buf) do { _Pragma("unroll") for (int i = 0; i < 2; ++i) *(LAS u32x4*)(lds + (buf) * BUFB + KOFF + (srow + 32 * i) * 272 + sch * 16) = kreg[i]; } while (0)
#define DIFF_LSTOREV(buf) do { _Pragma("unroll") for (int i = 0; i < 2; ++i) *(LAS u32x4*)(lds + (buf) * BUFB + VOFF + (srow + 32 * i) * DVS + sch * 16) = vreg[i]; } while (0)
    const int qme = q0 + wq * 32 + r32;
#define DIFF_INIT(P0, P1, t) do { const int qrel_ = qme - 64 * (t); \
        if (q0 + wq * 32 - (64 * (t) + 63) >= 113) { const float v_ = b31 - mref; _Pragma("unroll") for (int r = 0; r < 16; ++r) { P0[r] = v_; P1[r] = v_; } } \
        else { _Pragma("unroll") for (int r = 0; r < 16; ++r) { const int d0_ = qrel_ - crow(r, hi), d1_ = d0_ - 32; \
                 P0[r] = bt[min(max(d0_, 0), 127)] - mref; P1[r] = bt[min(max(d1_, 0), 127)] - mref; } } } while (0)
    DIFF_GLOADK(0); DIFF_GLOADV(0); DIFF_LSTOREK(0); DIFF_LSTOREV(0);
    DIFF_GLOADK(1); DIFF_LSTOREK(1);
    __syncthreads();
    const float b31 = bt[127];
    f32x16 s0, s1, n0 = {}, n1 = {};
    DIFF_INIT(s0, s1, 0); DIFF_QK(s0, s1, lds + KOFF + map * 128);
#define DIFF_ITER(t, S0, S1, N0, N1) do { \
        if ((t) + 2 < NT) DIFF_GLOADK((t) + 2); \
        if ((t) + 1 < NT) DIFF_GLOADV((t) + 1); \
        const int jb = (t) - (NT - 2); \
        const bool active = (jb < 0) || (jb <= (wq >> 1)); \
        const bool act_next = ((t) + 1 < NT) && ((jb + 1 < 0) || (jb + 1 <= (wq >> 1))); \
        if (act_next) { DIFF_INIT(N0, N1, (t) + 1); DIFF_QK(N0, N1, lds + (((t) + 1) & 1) * BUFB + KOFF + map * 128); } \
        if (active) { const bool domask = (jb >= 0) && (64 * jb + 63 > 32 * wq); \
            attn_sm_pv<4, 320>(S0, S1, N0, N1, act_next, lds + ((t) & 1) * BUFB + VOFF, o, mref, lrun, (t) == 0, domask, qme - 64 * (t), wsf, r32, hi); } \
        if ((t) + 2 < NT) DIFF_LSTOREK((t) & 1); \
        if ((t) + 1 < NT) DIFF_LSTOREV(((t) + 1) & 1); \
        __syncthreads(); } while (0)
#define DIFF_STEADY(t, S0, S1, N0, N1) do { \
        DIFF_GLOADK((t) + 2); \
        diff_steady_step(S0, S1, N0, N1, lds + (((t) + 1) & 1) * BUFB + KOFF + map * 128, lds + ((t) & 1) * BUFB + VOFF, qlds, o, mref, lrun, b31, wsf, r32, hi, rmc, sbase + O_DV + (size_t)(64 * ((t) + 1)) * QP, (size_t)32 * QP, vreg); \
        DIFF_LSTOREK((t) & 1); DIFF_LSTOREV(((t) + 1) & 1); \
        __syncthreads(); } while (0)
    DIFF_ITER(0, s0, s1, n0, n1);
    int t = 1;
    float rmc = 0.f;
    if (t + 1 <= NT - 6) rmc = rowmax32(n0, n1);
    for (; t + 1 <= NT - 6; t += 2) { DIFF_STEADY(t, n0, n1, s0, s1); DIFF_STEADY(t + 1, s0, s1, n0, n1); }
    for (; t + 1 < NT; t += 2) { DIFF_ITER(t, n0, n1, s0, s1); DIFF_ITER(t + 1, s0, s1, n0, n1); }
    DIFF_ITER(NT - 1, n0, n1, s0, s1);
#undef DIFF_STEADY
#undef DIFF_ITER
#undef DIFF_GLOADK
#undef DIFF_GLOADV
#undef DIFF_LSTOREK
#undef DIFF_LSTOREV
#undef DIFF_INIT
#undef DIFF_QK
    const float lt = half_sum(lrun);
    if (hi == 0) wsf[r32] = fast_rcp(lt) * (map ? lam : 1.0f);
    asm volatile("s_waitcnt lgkmcnt(0)" ::: "memory");
    float il[16];
#pragma unroll
    for (int r = 0; r < 16; ++r) il[r] = wsf[crow(r, hi)];
    if (map == 1) {
#pragma unroll
        for (int d = 0; d < 4; ++d)
#pragma unroll
            for (int r = 0; r < 16; ++r) xch[((wq * 4 + d) * 16 + r) * 64 + lane] = o[d][r] * il[r];
    }
    __syncthreads();
    if (map == 0) {
        float ssq[16];
#pragma unroll
        for (int r = 0; r < 16; ++r) ssq[r] = 0.f;
#pragma unroll
        for (int d = 0; d < 4; ++d)
#pragma unroll
            for (int r = 0; r < 16; ++r) { const float v = o[d][r] * il[r] - xch[((wq * 4 + d) * 16 + r) * 64 + lane]; o[d][r] = v; ssq[r] += v * v; }
#pragma unroll
        for (int r = 0; r < 16; ++r) {
#pragma unroll
            for (int s = 1; s < 32; s <<= 1) ssq[r] += __shfl_xor(ssq[r], s);
        }
        const float post = 1.0f - lam_init;
        float gsub[4];
#pragma unroll
        for (int d = 0; d < 4; ++d) gsub[d] = P.in[I_SUBG][l * 128 + 32 * d + r32] * post;
        bf16_t* Ow = proj + O_DQ + (rowb + q0 + wq * 32) * QP + h * 128;
#pragma unroll
        for (int r = 0; r < 16; ++r) { const int q = crow(r, hi); const float rstd = fast_rsq(ssq[r] * (1.0f / 128.0f) + EPS);
#pragma unroll
            for (int d = 0; d < 4; ++d) if (!dry || o[d][r] == 1.2345e30f) Ow[(size_t)q * QP + 32 * d + r32] = (bf16_t)f2bf(o[d][r] * rstd * gsub[d]); }
    }
    __syncthreads();
}

__device__ __forceinline__ void ffn_fixup(const Params& P, int l, int pm, int tid) {
    unsigned char* ws_ = launder_ptr(P.ws);
    const float* halo = (const float*)(ws_ + WS_HALO); bf16_t* act = (bf16_t*)(ws_ + WS_ACT);
    const float* cw = P.in[I_FCW] + (size_t)l * 3 * DFF2; const float* cb = P.in[I_FCB] + (size_t)l * DFF2;
    for (int it = tid; it < 4 * (DFF / 4); it += 512) {
        const int bi = it / (DFF / 4), ch0 = 4 * (it % (DFF / 4)); const int blk = pm * 4 + bi;
        const f32x4 z = {0.f, 0.f, 0.f, 0.f};
        f32x4 gm2 = z, gm1 = z, vm2 = z, vm1 = z;
        if ((blk & 31) != 0) { const float* hp = halo + ((size_t)(blk - 1) * 4 + 2) * DFF2 + ch0;
            gm2 = *(const f32x4*)hp; vm2 = *(const f32x4*)(hp + DFF); gm1 = *(const f32x4*)(hp + DFF2); vm1 = *(const f32x4*)(hp + DFF2 + DFF); }
        const float* hc = halo + ((size_t)blk * 4) * DFF2 + ch0;
        const f32x4 g0 = *(const f32x4*)hc, v0 = *(const f32x4*)(hc + DFF), g1 = *(const f32x4*)(hc + DFF2), v1 = *(const f32x4*)(hc + DFF2 + DFF);
        const f32x4 wg0 = *(const f32x4*)(cw + ch0), wg1 = *(const f32x4*)(cw + DFF2 + ch0), wg2 = *(const f32x4*)(cw + 2 * DFF2 + ch0), bg = *(const f32x4*)(cb + ch0);
        const f32x4 wv0 = *(const f32x4*)(cw + DFF + ch0), wv1 = *(const f32x4*)(cw + DFF2 + DFF + ch0), wv2 = *(const f32x4*)(cw + 2 * DFF2 + DFF + ch0), bv = *(const f32x4*)(cb + DFF + ch0);
        { const f32x4 cg = bg + wg0 * gm2 + wg1 * gm1 + wg2 * g0, cv = bv + wv0 * vm2 + wv1 * vm1 + wv2 * v0;
          u32x2 w; w.x = pk2(gelu_tanh(cg[0]) * cv[0], gelu_tanh(cg[1]) * cv[1]); w.y = pk2(gelu_tanh(cg[2]) * cv[2], gelu_tanh(cg[3]) * cv[3]);
          *(u32x2*)(act + (size_t)(blk * 64) * DFF + ch0) = w; }
        { const f32x4 cg = bg + wg0 * gm1 + wg1 * g0 + wg2 * g1, cv = bv + wv0 * vm1 + wv1 * v0 + wv2 * v1;
          u32x2 w; w.x = pk2(gelu_tanh(cg[0]) * cv[0], gelu_tanh(cg[1]) * cv[1]); w.y = pk2(gelu_tanh(cg[2]) * cv[2], gelu_tanh(cg[3]) * cv[3]);
          *(u32x2*)(act + (size_t)(blk * 64 + 1) * DFF + ch0) = w; }
    }
}

__device__ __forceinline__ void final_norm(float* x, const float* g, int gw, int NGW, int lane) {
    f32x4 gv[4];
#pragma unroll
    for (int j = 0; j < 4; ++j) gv[j] = ((const f32x4*)g)[lane + 64 * j];
    for (int m = gw; m < MTOK; m += NGW) {
        f32x4* xr = (f32x4*)(x + (size_t)m * DM) + lane;
        f32x4 v[4]; float ss = 0.f;
#pragma unroll
        for (int j = 0; j < 4; ++j) { v[j] = xr[64 * j]; ss += (v[j].x * v[j].x + v[j].y * v[j].y) + (v[j].z * v[j].z + v[j].w * v[j].w); }
        const float rstd = fast_rsq(wave_sum(ss) * (1.0f / DM) + EPS);
#pragma unroll
        for (int j = 0; j < 4; ++j) xr[64 * j] = v[j] * rstd * gv[j];
    }
}


#define XB_TMO      128
#define XB_XCNT(j)  (256  + 64 * (j))
#define XB_XSUB(j)  (1280 + 64 * (j))
#define XB_XGEN(j)  (2304 + 64 * (j))
#define XB_TOP      3328
#define XB_TOPGEN   3392
#define XCD_BAR_WORDS 3456
#define XB_SPIN_CAP (1u << 22)
__device__ __forceinline__ unsigned xb_ld(unsigned* p)              { return __hip_atomic_load(p, __ATOMIC_RELAXED, __HIP_MEMORY_SCOPE_AGENT); }
__device__ __forceinline__ unsigned xb_add(unsigned* p, unsigned v) { return __hip_atomic_fetch_add(p, v, __ATOMIC_RELAXED, __HIP_MEMORY_SCOPE_AGENT); }
__device__ __forceinline__ unsigned xb_xcc_id() { return (unsigned)__builtin_amdgcn_s_getreg((3 << 11) | 20) & 0xFu; }
#define XB_SPIN(cond, bar) do { unsigned _sp = 0; while (cond) { __builtin_amdgcn_s_sleep(1); \
    if ((++_sp & 255u) == 0u) { if (xb_ld(&(bar)[XB_TMO])) break; if (_sp > XB_SPIN_CAP) { atomicAdd(&(bar)[XB_TMO], 1u); break; } } } } while (0)
struct XcdBarrier { unsigned* bar; unsigned x; volatile LAS unsigned* st; };
__device__ __forceinline__ XcdBarrier xcd_barrier_post(unsigned* bar, volatile LAS unsigned* st) {
    XcdBarrier b; b.bar = bar; b.x = xb_xcc_id(); b.st = st;
    if (threadIdx.x == 0) (void)xb_add(&bar[XB_XCNT(b.x)], 1u);
    return b;
}
__device__ __forceinline__ void xcd_barrier_complete(unsigned* bar, unsigned x, unsigned& nloc, unsigned& nx) {
    const unsigned G = gridDim.x * gridDim.y * gridDim.z;
    unsigned sum, cnt, mine, sp = 0u;
    for (;;) {
        sum = 0u; cnt = 0u; mine = 0u;
#pragma unroll
        for (unsigned j = 0; j < 16; ++j) { const unsigned c = xb_ld(&bar[XB_XCNT(j)]); sum += c; cnt += (c > 0u) ? 1u : 0u; mine = (j == x) ? c : mine; }
        if (sum == G) break;
        __builtin_amdgcn_s_sleep(1);
        if ((++sp & 255u) == 0u) { if (xb_ld(&bar[XB_TMO])) break; if (sp > XB_SPIN_CAP) { atomicAdd(&bar[XB_TMO], 1u); break; } }
    }
    nloc = mine > 0u ? mine : 1u; nx = cnt > 0u ? cnt : 1u;
}
__device__ __forceinline__ void xcd_barrier(const XcdBarrier& b) {
    asm volatile("s_waitcnt vmcnt(0)" ::: "memory");
    __syncthreads();
    if (threadIdx.x == 0) {
        unsigned* bar = b.bar;
        __builtin_amdgcn_s_waitcnt(0);
        unsigned nloc = b.st[0], nx = b.st[1];
        if (nloc == 0u) { xcd_barrier_complete(bar, b.x, nloc, nx); b.st[0] = nloc; b.st[1] = nx; }
        const unsigned old = xb_add(&bar[XB_XSUB(b.x)], 1u);
        const unsigned gen = old / nloc;
        if (old + 1u == (gen + 1u) * nloc) {
            __builtin_amdgcn_fence(__ATOMIC_RELEASE, "agent");
            asm volatile("s_waitcnt vmcnt(0)" ::: "memory");
            const unsigned og = xb_add(&bar[XB_TOP], 1u);
            const unsigned tg = og / nx;
            if (og + 1u == (tg + 1u) * nx) xb_add(&bar[XB_TOPGEN], 1u);
            else XB_SPIN(xb_ld(&bar[XB_TOPGEN]) == tg, bar);
            __builtin_amdgcn_fence(__ATOMIC_ACQUIRE, "agent");
            xb_add(&bar[XB_XGEN(b.x)], 1u);
            asm volatile("s_waitcnt vmcnt(0)" ::: "memory");
        } else {
            XB_SPIN(xb_ld(&bar[XB_XGEN(b.x)]) == gen, bar);
            __builtin_amdgcn_fence(__ATOMIC_ACQUIRE, "agent");
            asm volatile("s_waitcnt vmcnt(0)" ::: "memory");
        }
    }
    __syncthreads();
}

#ifndef PHMASK
#define PHMASK 0xffffffffu
#endif
#define PH(n) ((PHMASK >> (n)) & 1u)
#ifndef PROBE_RG
#define PROBE_RG 0
#endif
#ifndef PROBE_DIFF
#define PROBE_DIFF 0
#endif
#ifndef PROBE_FOX
#define PROBE_FOX 0
#endif
#ifndef PROBE_SYNC
#define PROBE_SYNC 0
#endif
#ifndef PROBE_G1
#define PROBE_G1 0
#endif
__device__ __forceinline__ int launder_s(int v) { asm volatile("" : "+s"(v)); return v; }
#define PHASE_BEGIN { const int tid = launder_tid(); const int lane = tid & 63; const int wid = __builtin_amdgcn_readfirstlane(tid >> 6); \
    const int G = launder_s((int)gridDim.x), bx = launder_s((int)blockIdx.x); const int vcu = (G % 8 == 0) ? (bx % 8) * (G / 8) + bx / 8 : bx; \
    const int gw = vcu * 8 + wid, NGW = G * 8; unsigned char* ws = launder_ptr(P.ws); bf16_t* hbuf = (bf16_t*)(ws + WS_H); bf16_t* proj = (bf16_t*)(ws + WS_P); \
    float* xres = launder_ptr(P.out); const float* xin = (l == 0) ? launder_ptr(P.in[I_X]) : (const float*)xres; \
    (void)tid; (void)lane; (void)wid; (void)vcu; (void)gw; (void)NGW; (void)hbuf; (void)proj; (void)xin; (void)bx;
#define PHASE_END }
__global__ void __launch_bounds__(512, 2) fwd_megakernel(Params P) {
    extern __shared__ __attribute__((aligned(16))) unsigned char lds_raw[];
    LAS unsigned char* lds = (LAS unsigned char*)lds_raw;
    cg::grid_group grid = cg::this_grid();
    volatile LAS unsigned* bst = (volatile LAS unsigned*)(lds + LDS_BYTES - 64);
    if (threadIdx.x < 2) bst[threadIdx.x] = 0u;
    __syncthreads();
    (void)xcd_barrier_post((unsigned*)P.ws, bst);
#define GRID_SYNC() do { XcdBarrier xb_; xb_.bar = (unsigned*)launder_ptr(P.ws); xb_.x = xb_xcc_id(); xb_.st = (volatile LAS unsigned*)((LAS unsigned char*)lds_raw + LDS_BYTES - 64); xcd_barrier(xb_); } while (0)

    for (int l = 0; l < DEPTH; ++l) {
#if PH(1)
        PHASE_BEGIN
        convert_weights(P, l, lds, gw, NGW, wid, lane);
        __syncthreads();
        PHASE_END
#endif
#if PH(2)
        PHASE_BEGIN
        rmsnorm_rows<true>(xin, P.in[I_N1G] + l * DM, hbuf, P, l, lds, gw, NGW, lane);
        PHASE_END
#endif
        if (l == 0) grid.sync(); else GRID_SYNC();
#if PH(3)
        PHASE_BEGIN
        for (int b = bx; b < BATCH; b += G) cumsum_logf(P, b, wid, lane);
        for (int i = vcu * 512 + tid; i < MTOK; i += G * 512) ((float*)(ws + WS_SUMSQ))[i] = 0.f;
        PHASE_END
#endif
#if PH(4)
        PHASE_BEGIN
        pg8::Gemm g{hbuf, (const bf16_t*)(ws + WS_WIN), DM, DM, MTOK, 5120, DM}; pg8::StaticOrder S; S.init(MTOK, 5120, G, bx);
        pg8::EpiProj E{proj}; for (int rep = PROBE_G1; rep >= 0; --rep) pg8::gemm_phase(lds, g, S, E);
        for (int rep = 0; rep < PROBE_SYNC; ++rep) GRID_SYNC();
        PHASE_END
#endif
        GRID_SYNC();
#if PH(5)
        PHASE_BEGIN
        for (int rep = PROBE_RG; rep >= 0; --rep) for (int u = vcu; u < BATCH * 16; u += G) rglru_unit(P, l, u, lds, rep > 0);
        PHASE_END
#endif
#if PH(6)
        PHASE_BEGIN
            const float lam_init = (l == 0) ? 0.2f : 0.35550907f;
            float d1 = 0.f, d2 = 0.f;
            { const float* a1 = P.in[I_LQ1] + l * 64; const float* b1 = P.in[I_LK1] + l * 64; const float* a2 = P.in[I_LQ2] + l * 64; const float* b2 = P.in[I_LK2] + l * 64;
              d1 = wave_sum(a1[lane] * b1[lane]); d2 = wave_sum(a2[lane] * b2[lane]); }
            const float lam = fast_exp2(d1 * LOG2E) - fast_exp2(d2 * LOG2E) + lam_init;
            for (int rep = PROBE_DIFF; rep >= 0; --rep) for (int p = vcu; p < BATCH * 4 * 8; p += G) { const int bh = p >> 3, s = p & 7;
                diff_unit(P, l, bh >> 2, bh & 3, s, lam, lam_init, lds, rep > 0); diff_unit(P, l, bh >> 2, bh & 3, 15 - s, lam, lam_init, lds, rep > 0); }
        PHASE_END
#endif
#if PH(7)
        PHASE_BEGIN
        for (int rep = PROBE_FOX; rep >= 0; --rep) for (int p = vcu; p < BATCH * 8 * 4; p += G) { const int bh = p >> 2, s = p & 3;
            fox_unit(P, bh >> 3, bh & 7, s, lds, rep > 0); fox_unit(P, bh >> 3, bh & 7, 7 - s, lds, rep > 0); }
        PHASE_END
#endif
        GRID_SYNC();
#if PH(8)
        PHASE_BEGIN
        pg8::Gemm g{hbuf, (const bf16_t*)(ws + WS_WIN) + (size_t)5120 * DM, DM, DM, MTOK, 3072, DM}; pg8::StaticOrder S; S.init(MTOK, 3072, G, bx);
        pg8::EpiGates E{proj, P.in[I_GATEB] + l * 3072}; pg8::gemm_phase(lds, g, S, E);
        PHASE_END
#endif
        GRID_SYNC();
#if PH(9)
        PHASE_BEGIN
        pg8::StaticOrder S; S.init(MTOK, DM, G, bx);
        static_assert(WS_WBR_DIFF == WS_WBR_RNN + 2 * MiB && WS_WBR_FOX == WS_WBR_RNN + 4 * MiB, "Gemm3 segment arithmetic");
        pg8::Gemm3 g{proj, (const bf16_t*)(ws + WS_WBR_RNN), DM};
        pg8::EpiMerge3 E{proj, hbuf}; pg8::gemm_phase3(lds, g, S, E);
        PHASE_END
#endif
        GRID_SYNC();
#if PH(10)
        PHASE_BEGIN
        pg8::Gemm g{hbuf, (const bf16_t*)(ws + WS_WOUT), DM, DM, MTOK, DM, DM}; pg8::StaticOrder S; S.init(MTOK, DM, G, bx);
        pg8::EpiResidNorm E{xin, xres, (bf16_t*)(ws + WS_XG), P.in[I_N2G] + l * DM, (float*)(ws + WS_SUMSQ)}; pg8::gemm_phase(lds, g, S, E);
        PHASE_END
#endif
        GRID_SYNC();
#if PH(12)
        PHASE_BEGIN
        pg8::Gemm g{(const bf16_t*)(ws + WS_XG), (const bf16_t*)(ws + WS_WUP), DM, DM, MTOK, DFF2, DM}; pg8::StaticOrder S; S.init(MTOK, DFF2, G, bx);
        pg8::EpiFfn E{(bf16_t*)(ws + WS_ACT), (float*)(ws + WS_HALO), P.in[I_FCW] + (size_t)l * 3 * DFF2, P.in[I_FCB] + (size_t)l * DFF2, (const float*)(ws + WS_SUMSQ)};
        pg8::gemm_phase(lds, g, S, E);
        PHASE_END
#endif
        GRID_SYNC();
#if PH(14)
        PHASE_BEGIN
        pg8::StaticOrder S; S.init(MTOK, DM, G, bx);
        { pg8::Unit u; for (int i = 0; S.next(i, u); ++i) ffn_fixup(P, l, u.pm, tid); }
        asm volatile("s_waitcnt vmcnt(0)" ::: "memory"); __syncthreads();
        pg8::Gemm g{(const bf16_t*)(ws + WS_ACT), (const bf16_t*)(ws + WS_WDOWN), DFF, DFF, MTOK, DM, DFF};
        pg8::EpiResid E{xres, xres, 0}; pg8::gemm_phase(lds, g, S, E);
        PHASE_END
#endif
        GRID_SYNC();
    }
#if PH(15)
    { const int l = 1; PHASE_BEGIN
    final_norm(xres, P.in[I_FINALG], gw, NGW, lane);
    PHASE_END }
#endif
}

extern "C" void kernel_launch(void* const* d_in, const int* in_sizes, int n_in, void* d_out, int out_size, void* d_ws, size_t ws_size, hipStream_t stream) {
    static int grid = 0;
    if (grid == 0) {
        if (n_in != 28 || in_sizes[0] != MTOK * DM || out_size != MTOK * DM || ws_size < WS_END) {
            fprintf(stderr, "kernel_launch: unexpected shapes (n_in %d, in0 %d, out %d, ws %zu)\n", n_in, n_in > 0 ? in_sizes[0] : -1, out_size, ws_size); grid = -1; return; }
        int dev = 0, cus = 0, per_cu = 0;
        hipGetDevice(&dev); hipDeviceGetAttribute(&cus, hipDeviceAttributeMultiprocessorCount, dev);
        if (hipFuncSetAttribute((const void*)fwd_megakernel, hipFuncAttributeMaxDynamicSharedMemorySize, LDS_BYTES) != hipSuccess) { fprintf(stderr, "hipFuncSetAttribute failed\n"); grid = -1; return; }
        if (hipOccupancyMaxActiveBlocksPerMultiprocessor(&per_cu, (const void*)fwd_megakernel, 512, LDS_BYTES) != hipSuccess || per_cu < 1) per_cu = 1;
        (void)hipGetLastError();
        grid = cus * per_cu;
    }
    if (grid < 0) return;
    if (hipMemsetAsync(d_ws, 0, 16384, stream) != hipSuccess) { fprintf(stderr, "memset failed\n"); return; }
    Params p{};
    for (int i = 0; i < 28; ++i) p.in[i] = (const float*)d_in[i];
    p.out = (float*)d_out; p.ws = (unsigned char*)d_ws;
    void* args[] = {&p};
    hipError_t e = hipLaunchCooperativeKernel((const void*)fwd_megakernel, dim3(grid), dim3(512), args, LDS_BYTES, stream);
    if (e != hipSuccess) fprintf(stderr, "cooperative launch failed: %s (grid %d)\n", hipGetErrorString(e), grid);
}
```

```cpp
#include <hip/hip_runtime.h>
#include <hip/hip_cooperative_groups.h>
#include <cstdio>
#include <cstdint>
#include <cmath>
namespace cg = cooperative_groups;

#define LAS __attribute__((address_space(3)))
typedef unsigned short bf16_t;
typedef short bf16x8 __attribute__((ext_vector_type(8)));
typedef short s16x4 __attribute__((ext_vector_type(4)));
typedef float f32x4 __attribute__((ext_vector_type(4)));
typedef float f32x2 __attribute__((ext_vector_type(2)));
typedef float f32x16 __attribute__((ext_vector_type(16)));
typedef unsigned u32x4 __attribute__((ext_vector_type(4)));
typedef unsigned u32x2 __attribute__((ext_vector_type(2)));

constexpr int DM = 1024, BATCH = 16, SEQ = 2048, MTOK = BATCH * SEQ, DEPTH = 2;
constexpr int NIN = 8200, DFF = 2816, DFF2 = 5632;
constexpr int XP = 1024, QP = 512;
constexpr size_t MT = (size_t)BATCH * SEQ;
constexpr size_t O_XR = 0, O_GR = MT * XP, O_DQ = 2 * MT * XP, O_DK = O_DQ + MT * QP, O_DV = O_DK + MT * QP, O_FQ = O_DV + MT * QP, O_FK = O_FQ + MT * QP, O_FV = O_FK + MT * QP;
constexpr float LOG2E = 1.4426950408889634f;
constexpr float EPS = 1e-6f;
constexpr size_t MiB = 1u << 20;
constexpr size_t WS_WIN = 1 * MiB, WS_WBR_RNN = 17 * MiB, WS_WBR_DIFF = 19 * MiB, WS_WBR_FOX = 21 * MiB, WS_WOUT = 23 * MiB, WS_WUP = 25 * MiB,
                 WS_WDOWN = 36 * MiB, WS_RGR = 42 * MiB, WS_RGI = 42 * MiB + 256 * 1024, WS_SUMSQ = 43 * MiB, WS_C = 44 * MiB, WS_LOGF = 45 * MiB, WS_H = 46 * MiB, WS_P = 110 * MiB,
                 WS_XG = WS_P, WS_ACT = 174 * MiB, WS_HALO = 350 * MiB, WS_END = 430 * MiB;
constexpr int LDS_BYTES = 147456;
constexpr int MHALF = MTOK / 2;

__device__ __forceinline__ unsigned f2bf(float f) { unsigned u = __builtin_bit_cast(unsigned, f); return (u + 0x7fffu + ((u >> 16) & 1u)) >> 16; }
__device__ __forceinline__ unsigned pk2(float lo, float hi) { return f2bf(lo) | (f2bf(hi) << 16); }
__device__ __forceinline__ float bf2f(unsigned short b) { return __builtin_bit_cast(float, (unsigned)b << 16); }
__device__ __forceinline__ float bflo(unsigned w) { return __builtin_bit_cast(float, w << 16); }
__device__ __forceinline__ float bfhi(unsigned w) { return __builtin_bit_cast(float, w & 0xffff0000u); }
typedef __bf16 bf16x2_t __attribute__((ext_vector_type(2)));
__device__ __forceinline__ unsigned cvt_pk_bf16(float lo, float hi) { const f32x2 v = {lo, hi}; const bf16x2_t b = __builtin_convertvector(v, bf16x2_t); return __builtin_bit_cast(unsigned, b); }
__device__ __forceinline__ float fast_exp2(float x) { return __builtin_amdgcn_exp2f(x); }
__device__ __forceinline__ float fast_rcp(float x) { return __builtin_amdgcn_rcpf(x); }
__device__ __forceinline__ float fast_log2(float x) { return __builtin_amdgcn_logf(x); }
__device__ __forceinline__ float fast_rsq(float x) { return __builtin_amdgcn_rsqf(x); }
__device__ __forceinline__ float log1p_small(float e) { return e < 0.01f ? e * (1.0f - e * (0.5f - e * 0.33333334f)) : fast_log2(1.0f + e) * 0.6931471806f; }
__device__ __forceinline__ float sigmoidf_(float x) { return fast_rcp(1.0f + fast_exp2(-x * LOG2E)); }
__device__ __forceinline__ float gelu_tanh(float x) { const float t = x + 0.044715f * x * x * x; return x * fast_rcp(1.0f + fast_exp2(-2.3022082f * t)); }
__device__ __forceinline__ float wave_sum(float v) {
#pragma unroll
    for (int o = 1; o < 64; o <<= 1) v += __shfl_xor(v, o);
    return v;
}
__device__ __forceinline__ int launder_tid() { int t = threadIdx.x; asm volatile("" : "+v"(t)); return t; }
template <class T> __device__ __forceinline__ T* launder_ptr(T* p) { asm volatile("" : "+s"(p)); return p; }
__device__ __forceinline__ int crow(int r, int hi) { return (r & 3) + 8 * (r >> 2) + 4 * hi; }

namespace pg8 {
constexpr int BM = 256, BK = 64, HALF = 128, HTB = HALF * BK * 2, STAGE_BYTES = 8 * HTB, NXCD = 8, WGM = 8;
__host__ __device__ __forceinline__ int lds_byte(int r, int c) { const int st = (r >> 4) * 2 + (c >> 5), rr = r & 15, cc = c & 31, ob = rr * 64 + cc * 2; return st * 1024 + (ob ^ (((ob >> 9) & 1) << 5)); }
__host__ __device__ __forceinline__ void stage_rc(int b, int& R, int& C) { const int st = b / 1024, sb = b % 1024, swz = sb ^ (((sb >> 9) & 1) << 5); R = (st >> 1) * 16 + swz / 64; C = (st & 1) * 32 + (swz % 64) / 2; }
__host__ __device__ __forceinline__ int perm32(int rho) { const int n = rho >> 4, i = rho & 15; return 8 * (i >> 2) + 4 * n + (i & 3); }

struct Unit { int pm, pn; };
struct Gemm { const bf16_t* A; const bf16_t* Bt; int lda, ldb, M, N, K; };

struct StaticOrder {
    int nM, nN, nwg, G, c;
    __host__ __device__ void init(int M, int N, int G_, int c_) { nM = M / BM; nN = N / BM; nwg = nM * nN; G = G_; c = c_; }
    __host__ __device__ bool next(int i, Unit& u) const {
        const long L = (long)i * G + c; if (L >= nwg) return false;
        int wgid = (int)L; { const int q = nwg / NXCD, r = nwg % NXCD, xcd = wgid % NXCD, off = wgid / NXCD; wgid = (xcd < r ? xcd * (q + 1) : r * (q + 1) + (xcd - r) * q) + off; }
        const int nig = WGM * nN, gid = wgid / nig, fm = gid * WGM, gsz = (nM - fm) < WGM ? (nM - fm) : WGM;
        u.pm = fm + ((wgid % nig) % gsz); u.pn = (wgid % nig) / gsz; return true;
    }
};

template <class Epi, class Sched>
__device__ __forceinline__ void gemm_phase(LAS unsigned char* lds, const Gemm g, const Sched& S, const Epi& E) {
    const int tid = launder_tid(), wid = __builtin_amdgcn_readfirstlane(tid >> 6), lane = tid & 63, wr = wid >> 2, wc = wid & 3, fr = lane & 15, fq = lane >> 4;
    const int K = g.K, nt = K / BK;
    unsigned voffA[2], voffB[2];
#pragma unroll
    for (int i = 0; i < 2; ++i) { int R, C; stage_rc(tid * 16 + i * 8192, R, C); const int Rb = (R & ~31) + perm32(R & 31);
        voffA[i] = (unsigned)(R * g.lda + C) * 2u; voffB[i] = (unsigned)(Rb * g.ldb + C) * 2u; }
    const size_t kstep = (size_t)(BK * 2);
    const size_t hstepA = (size_t)HALF * g.lda * 2, hstepB = (size_t)HALF * g.ldb * 2;
    const size_t tstepA = 2 * hstepA, tstepB = 2 * hstepB;
    const unsigned ldsw = (unsigned)wid * 1024u;
    const int aoff = lds_byte(wr * 64 + fr, fq * 8), boff = lds_byte(wc * 32 + fr, fq * 8);
#define PG8_SA(b, h) (((b) * 2 + (h)) * HTB)
#define PG8_SB(b, h) ((4 + (b) * 2 + (h)) * HTB)
#define PG8_STAGE(bufoff, gbase, voff) do { _Pragma("unroll") for (int _i = 0; _i < 2; ++_i) \
        __builtin_amdgcn_global_load_lds((const unsigned*)((const char*)(gbase) + (voff)[_i]), (LAS unsigned*)(lds + (bufoff) + ldsw + _i * 8192), 16, 0, 0); } while (0)
#define PG8_LDA(dst, b, h) do { _Pragma("unroll") for (int m = 0; m < 4; ++m) _Pragma("unroll") for (int k = 0; k < 2; ++k) dst[m][k] = *(const LAS bf16x8*)(lds + PG8_SA(b, h) + aoff + m * 2048 + k * 1024); } while (0)
#define PG8_LDB(dst, b, h) do { _Pragma("unroll") for (int n = 0; n < 2; ++n) _Pragma("unroll") for (int k = 0; k < 2; ++k) dst[n][k] = *(const LAS bf16x8*)(lds + PG8_SB(b, h) + boff + n * 2048 + k * 1024); } while (0)
#define PG8_MMA(ai, bj, At, Bt) do { __builtin_amdgcn_s_setprio(1); _Pragma("unroll") for (int m = 0; m < 4; ++m) _Pragma("unroll") for (int n = 0; n < 2; ++n) _Pragma("unroll") for (int k = 0; k < 2; ++k) \
        acc[ai][bj][m][n] = __builtin_amdgcn_mfma_f32_16x16x32_bf16(Bt[n][k], At[m][k], acc[ai][bj][m][n], 0, 0, 0); __builtin_amdgcn_s_setprio(0); } while (0)
#define PG8_WAIT_V(n) asm volatile("s_waitcnt vmcnt(" #n ")" ::: "memory")
#define PG8_WAIT_L(n) asm volatile("s_waitcnt lgkmcnt(" #n ")" ::: "memory")
#define PG8_BAR __builtin_amdgcn_s_barrier()
#define PG8_SCHED __builtin_amdgcn_sched_barrier(0)
    Unit cur, nxt; int ui = 0;
    if (!S.next(0, cur)) return;
    f32x4 acc[2][2][4][2];
#pragma unroll
    for (int a = 0; a < 2; ++a)
#pragma unroll
        for (int b = 0; b < 2; ++b)
#pragma unroll
            for (int m = 0; m < 4; ++m)
#pragma unroll
                for (int n = 0; n < 2; ++n) acc[a][b][m][n] = (f32x4){0.f, 0.f, 0.f, 0.f};
    bf16x8 At[4][2], B0[2][2], B1[2][2];
    const char* cA = (const char*)g.A + (size_t)cur.pm * tstepA; const char* cB = (const char*)g.Bt + (size_t)cur.pn * tstepB;
    PG8_STAGE(PG8_SB(0, 0), cB, voffB); PG8_STAGE(PG8_SB(0, 1), cB + hstepB, voffB); PG8_STAGE(PG8_SA(0, 0), cA, voffA); PG8_STAGE(PG8_SA(0, 1), cA + hstepA, voffA);
    if (wr == 1) PG8_BAR;
    PG8_WAIT_V(2); PG8_BAR;
    PG8_STAGE(PG8_SB(1, 0), cB + kstep, voffB); PG8_STAGE(PG8_SA(1, 0), cA + kstep, voffA); PG8_STAGE(PG8_SB(1, 1), cB + hstepB + kstep, voffB);
    PG8_WAIT_V(6); PG8_BAR;
    for (;;) {
        const bool has_next = S.next(ui + 1, nxt);
        const char* nA = has_next ? (const char*)g.A + (size_t)nxt.pm * tstepA : cA; const char* nB = has_next ? (const char*)g.Bt + (size_t)nxt.pn * tstepB : cB;
        for (int t = 0; t < nt; t += 2) {
            const bool last = (t == nt - 2);
            const char* a1 = cA + (size_t)(t + 1) * kstep;
            const char* a2 = last ? nA : cA + (size_t)(t + 2) * kstep; const char* b2 = last ? nB : cB + (size_t)(t + 2) * kstep;
            const char* a3 = a2 + kstep; const char* b3 = b2 + kstep;
            PG8_LDB(B0, 0, 0); PG8_LDB(B1, 0, 1); PG8_SCHED; PG8_LDA(At, 0, 0); PG8_STAGE(PG8_SA(1, 1), a1 + hstepA, voffA);
            PG8_WAIT_V(8); PG8_WAIT_L(0); PG8_BAR; PG8_MMA(0, 0, At, B0); PG8_MMA(0, 1, At, B1); PG8_BAR; PG8_SCHED;
            PG8_LDA(At, 0, 1); PG8_STAGE(PG8_SB(0, 0), b2, voffB); PG8_STAGE(PG8_SB(0, 1), b2 + hstepB, voffB); PG8_STAGE(PG8_SA(0, 0), a2, voffA);
            PG8_WAIT_V(8); PG8_WAIT_L(0); PG8_BAR; PG8_MMA(1, 0, At, B0); PG8_MMA(1, 1, At, B1); PG8_BAR; PG8_SCHED;
            PG8_LDB(B0, 1, 0); PG8_LDB(B1, 1, 1); PG8_SCHED; PG8_LDA(At, 1, 0); PG8_STAGE(PG8_SA(0, 1), a2 + hstepA, voffA);
            PG8_WAIT_V(8); PG8_WAIT_L(0); PG8_BAR; PG8_MMA(0, 0, At, B0); PG8_MMA(0, 1, At, B1); PG8_BAR; PG8_SCHED;
            PG8_LDA(At, 1, 1); PG8_STAGE(PG8_SB(1, 0), b3, voffB); PG8_STAGE(PG8_SB(1, 1), b3 + hstepB, voffB); PG8_STAGE(PG8_SA(1, 0), a3, voffA);
            PG8_WAIT_V(8); PG8_WAIT_L(0); PG8_BAR; PG8_MMA(1, 0, At, B0); PG8_MMA(1, 1, At, B1); PG8_BAR; PG8_SCHED;
        }
        if (wr == 0) PG8_BAR;
        E(acc, cur, wr, wc, fr, fq);
        if (!has_next) break;
#pragma unroll
        for (int a = 0; a < 2; ++a)
#pragma unroll
            for (int b = 0; b < 2; ++b)
#pragma unroll
                for (int m = 0; m < 4; ++m)
#pragma unroll
                    for (int n = 0; n < 2; ++n) acc[a][b][m][n] = (f32x4){0.f, 0.f, 0.f, 0.f};
        cur = nxt; cA = nA; cB = nB; ++ui;
        if (wr == 1) PG8_BAR;
    }
    PG8_WAIT_V(0);
    PG8_BAR;
#undef PG8_SA
#undef PG8_SB
#undef PG8_STAGE
#undef PG8_LDA
#undef PG8_LDB
#undef PG8_MMA
#undef PG8_WAIT_V
#undef PG8_WAIT_L
#undef PG8_BAR
#undef PG8_SCHED
}

struct Gemm3 { const bf16_t* Abase; const bf16_t* Bbase; int ldb;
    __device__ __forceinline__ const bf16_t* A(int s) const { return Abase + (O_GR + (size_t)s * (O_DQ - O_GR) + (size_t)(s >> 1) * (O_FQ + O_GR - 2 * O_DQ)); }
    __device__ __forceinline__ int lda(int s) const { return s ? QP : XP; }
    __device__ __forceinline__ const bf16_t* B(int s) const { return Bbase + (size_t)s * (2u << 20) / 2; }
    __device__ __forceinline__ int nt(int s) const { return 16 >> ((s + 1) >> 1); } };
template <class Epi, class Sched>
__device__ __forceinline__ void gemm_phase3(LAS unsigned char* lds, const Gemm3 g, const Sched& S, const Epi& E) {
    const int tid = launder_tid(), wid = __builtin_amdgcn_readfirstlane(tid >> 6), lane = tid & 63, wr = wid >> 2, wc = wid & 3, fr = lane & 15, fq = lane >> 4;
    unsigned voffAx[2], voffAq[2], voffB[2];
#pragma unroll
    for (int i = 0; i < 2; ++i) { int R, C; stage_rc(tid * 16 + i * 8192, R, C); const int Rb = (R & ~31) + perm32(R & 31);
        voffAx[i] = (unsigned)(R * XP + C) * 2u; voffAq[i] = (unsigned)(R * QP + C) * 2u; voffB[i] = (unsigned)(Rb * g.ldb + C) * 2u; }
    const size_t kstep = (size_t)(BK * 2);
    const size_t hstepB = (size_t)HALF * g.ldb * 2, tstepB = 2 * hstepB;
    constexpr size_t hstepAx = (size_t)HALF * XP * 2, hstepAq = (size_t)HALF * QP * 2;
    const unsigned ldsw = (unsigned)wid * 1024u;
    const int aoff = lds_byte(wr * 64 + fr, fq * 8), boff = lds_byte(wc * 32 + fr, fq * 8);
#define PG8_SA(b, h) (((b) * 2 + (h)) * HTB)
#define PG8_SB(b, h) ((4 + (b) * 2 + (h)) * HTB)
#define PG8_STAGE(bufoff, gbase, voff) do { _Pragma("unroll") for (int _i = 0; _i < 2; ++_i) \
        __builtin_amdgcn_global_load_lds((const unsigned*)((const char*)(gbase) + (voff)[_i]), (LAS unsigned*)(lds + (bufoff) + ldsw + _i * 8192), 16, 0, 0); } while (0)
#define PG8_LDA(dst, b, h) do { _Pragma("unroll") for (int m = 0; m < 4; ++m) _Pragma("unroll") for (int k = 0; k < 2; ++k) dst[m][k] = *(const LAS bf16x8*)(lds + PG8_SA(b, h) + aoff + m * 2048 + k * 1024); } while (0)
#define PG8_LDB(dst, b, h) do { _Pragma("unroll") for (int n = 0; n < 2; ++n) _Pragma("unroll") for (int k = 0; k < 2; ++k) dst[n][k] = *(const LAS bf16x8*)(lds + PG8_SB(b, h) + boff + n * 2048 + k * 1024); } while (0)
#define PG8_MMA(ai, bj, At, Bt) do { __builtin_amdgcn_s_setprio(1); _Pragma("unroll") for (int m = 0; m < 4; ++m) _Pragma("unroll") for (int n = 0; n < 2; ++n) _Pragma("unroll") for (int k = 0; k < 2; ++k) \
        acc[ai][bj][m][n] = __builtin_amdgcn_mfma_f32_16x16x32_bf16(Bt[n][k], At[m][k], acc[ai][bj][m][n], 0, 0, 0); __builtin_amdgcn_s_setprio(0); } while (0)
#define PG8_WAIT_V(n) asm volatile("s_waitcnt vmcnt(" #n ")" ::: "memory")
#define PG8_WAIT_L(n) asm volatile("s_waitcnt lgkmcnt(" #n ")" ::: "memory")
#define PG8_BAR __builtin_amdgcn_s_barrier()
#define PG8_SCHED __builtin_amdgcn_sched_barrier(0)
    Unit cur, nxt; int ui = 0, seg = 0;
    if (!S.next(0, cur)) return;
    f32x4 acc[2][2][4][2];
#pragma unroll
    for (int a = 0; a < 2; ++a)
#pragma unroll
        for (int b = 0; b < 2; ++b)
#pragma unroll
            for (int m = 0; m < 4; ++m)
#pragma unroll
                for (int n = 0; n < 2; ++n) acc[a][b][m][n] = (f32x4){0.f, 0.f, 0.f, 0.f};
    bf16x8 At[4][2], B0[2][2], B1[2][2];
    const char* cA = (const char*)g.A(0) + (size_t)cur.pm * (2 * hstepAx); const char* cB = (const char*)g.B(0) + (size_t)cur.pn * tstepB;
    int nt = g.nt(0);
    unsigned voffA[2] = {voffAx[0], voffAx[1]}; size_t hstepA = hstepAx;
    PG8_STAGE(PG8_SB(0, 0), cB, voffB); PG8_STAGE(PG8_SB(0, 1), cB + hstepB, voffB); PG8_STAGE(PG8_SA(0, 0), cA, voffA); PG8_STAGE(PG8_SA(0, 1), cA + hstepA, voffA);
    if (wr == 1) PG8_BAR;
    PG8_WAIT_V(2); PG8_BAR;
    PG8_STAGE(PG8_SB(1, 0), cB + kstep, voffB); PG8_STAGE(PG8_SA(1, 0), cA + kstep, voffA); PG8_STAGE(PG8_SB(1, 1), cB + hstepB + kstep, voffB);
    PG8_WAIT_V(6); PG8_BAR;
    for (;;) {
        const int nseg = (seg == 2) ? 0 : seg + 1;
        bool has_next = true; if (seg == 2) has_next = S.next(ui + 1, nxt); else nxt = cur;
        const size_t nhstepA = has_next ? (nseg ? hstepAq : hstepAx) : hstepA;
        unsigned nvoffA[2]; nvoffA[0] = has_next ? (nseg ? voffAq[0] : voffAx[0]) : voffA[0]; nvoffA[1] = has_next ? (nseg ? voffAq[1] : voffAx[1]) : voffA[1];
        const char* nA = has_next ? (const char*)g.A(nseg) + (size_t)nxt.pm * (2 * nhstepA) : cA; const char* nB = has_next ? (const char*)g.B(nseg) + (size_t)nxt.pn * tstepB : cB;
        for (int t = 0; t < nt; t += 2) {
            const bool last = (t == nt - 2);
            const char* a1 = cA + (size_t)(t + 1) * kstep;
            const char* a2 = last ? nA : cA + (size_t)(t + 2) * kstep; const char* b2 = last ? nB : cB + (size_t)(t + 2) * kstep;
            const char* a3 = a2 + kstep; const char* b3 = b2 + kstep;
            unsigned vA2[2]; vA2[0] = last ? nvoffA[0] : voffA[0]; vA2[1] = last ? nvoffA[1] : voffA[1]; const size_t hA2 = last ? nhstepA : hstepA;
            PG8_LDB(B0, 0, 0); PG8_LDB(B1, 0, 1); PG8_SCHED; PG8_LDA(At, 0, 0); PG8_STAGE(PG8_SA(1, 1), a1 + hstepA, voffA);
            PG8_WAIT_V(8); PG8_WAIT_L(0); PG8_BAR; PG8_MMA(0, 0, At, B0); PG8_MMA(0, 1, At, B1); PG8_BAR; PG8_SCHED;
            PG8_LDA(At, 0, 1); PG8_STAGE(PG8_SB(0, 0), b2, voffB); PG8_STAGE(PG8_SB(0, 1), b2 + hstepB, voffB); PG8_STAGE(PG8_SA(0, 0), a2, vA2);
            PG8_WAIT_V(8); PG8_WAIT_L(0); PG8_BAR; PG8_MMA(1, 0, At, B0); PG8_MMA(1, 1, At, B1); PG8_BAR; PG8_SCHED;
            PG8_LDB(B0, 1, 0); PG8_LDB(B1, 1, 1); PG8_SCHED; PG8_LDA(At, 1, 0); PG8_STAGE(PG8_SA(0, 1), a2 + hA2, vA2);
            PG8_WAIT_V(8); PG8_WAIT_L(0); PG8_BAR; PG8_MMA(0, 0, At, B0); PG8_MMA(0, 1, At, B1); PG8_BAR; PG8_SCHED;
            PG8_LDA(At, 1, 1); PG8_STAGE(PG8_SB(1, 0), b3, voffB); PG8_STAGE(PG8_SB(1, 1), b3 + hstepB, voffB); PG8_STAGE(PG8_SA(1, 0), a3, vA2);
            PG8_WAIT_V(8); PG8_WAIT_L(0); PG8_BAR; PG8_MMA(1, 0, At, B0); PG8_MMA(1, 1, At, B1); PG8_BAR; PG8_SCHED;
        }
        if (wr == 0) PG8_BAR;
        E(acc, cur, seg, wr, wc, fr, fq);
        if (!has_next) break;
        if (seg == 2) {
#pragma unroll
        for (int a = 0; a < 2; ++a)
#pragma unroll
            for (int b = 0; b < 2; ++b)
#pragma unroll
                for (int m = 0; m < 4; ++m)
#pragma unroll
                    for (int n = 0; n < 2; ++n) acc[a][b][m][n] = (f32x4){0.f, 0.f, 0.f, 0.f};
        ++ui; }
        cur = nxt; cA = nA; cB = nB; seg = nseg; nt = g.nt(seg); voffA[0] = nvoffA[0]; voffA[1] = nvoffA[1]; hstepA = nhstepA;
        if (wr == 1) PG8_BAR;
    }
    PG8_WAIT_V(0);
    PG8_BAR;
#undef PG8_SA
#undef PG8_SB
#undef PG8_STAGE
#undef PG8_LDA
#undef PG8_LDB
#undef PG8_MMA
#undef PG8_WAIT_V
#undef PG8_WAIT_L
#undef PG8_BAR
#undef PG8_SCHED
}

#define EPI_LOOP_BEGIN \
    const int row0 = u.pm * BM + wr * 64 + fr; const int colt = u.pn * BM + wc * 32 + 8 * fq; \
    _Pragma("unroll") for (int ai = 0; ai < 2; ++ai) _Pragma("unroll") for (int m = 0; m < 4; ++m) { const int row = row0 + ai * HALF + m * 16; \
        _Pragma("unroll") for (int bj = 0; bj < 2; ++bj) { const int col = colt + bj * HALF; f32x4 v0 = acc[ai][bj][m][0], v1 = acc[ai][bj][m][1];
#define EPI_LOOP_END } if (m == 3) asm volatile("" ::: "memory"); }

__device__ __forceinline__ u32x4 pack8(f32x4 v0, f32x4 v1) { u32x4 w; w.x = cvt_pk_bf16(v0[0], v0[1]); w.y = cvt_pk_bf16(v0[2], v0[3]); w.z = cvt_pk_bf16(v1[0], v1[1]); w.w = cvt_pk_bf16(v1[2], v1[3]); return w; }

struct EpiProj {
    bf16_t* O;
    __device__ __forceinline__ void operator()(f32x4 (&acc)[2][2][4][2], const Unit& u, int wr, int wc, int fr, int fq) const {
        const int pn = u.pn; const int mode = (pn >= 4 && pn < 8) ? 1 : ((pn == 8 || pn == 9 || pn == 14 || pn == 15) ? 2 : 0);
        const float qs = 0.125f * LOG2E;
        const int q_ = pn - 8; const int pitch = (pn < 8) ? XP : QP;
        bf16_t* dst = (pn < 8) ? O + (size_t)(pn >> 2) * (MT * XP) + (pn & 3) * 256 : O + O_DQ + (size_t)(q_ >> 1) * (MT * QP) + (q_ & 1) * 256;
        EPI_LOOP_BEGIN
            if (mode == 1) {
#pragma unroll
                for (int e = 0; e < 4; ++e) { v0[e] = gelu_tanh(v0[e]); v1[e] = gelu_tanh(v1[e]); }
            } else if (mode == 2) { v0 = v0 * qs; v1 = v1 * qs; }
            *(u32x4*)(dst + (size_t)row * pitch + (col - u.pn * BM)) = pack8(v0, v1);
        EPI_LOOP_END
    }
};
__device__ __forceinline__ size_t gate_frag_off(int pm, int pnl, int wave, int ai, int m, int bj, int lane, size_t gbase) {
    const int blk = (((pm * 4 + pnl) * 8 + wave) * 16) + ((ai * 4 + m) * 2 + bj);
    return gbase + (size_t)blk * 512 + lane * 8;
}
struct EpiGates {
    bf16_t* O; const float* gb;
    __device__ __forceinline__ void operator()(f32x4 (&acc)[2][2][4][2], const Unit& u, int wr, int wc, int fr, int fq) const {
        const int b = u.pn >> 2; const size_t cbase = (size_t)b * (b == 1 ? O_DK : O_FK / 2);     const int wave = wr * 4 + wc, lane = fq * 16 + fr;
        EPI_LOOP_BEGIN
            (void)row;
            const f32x4 b0 = *(const f32x4*)(gb + col), b1 = *(const f32x4*)(gb + col + 4);
#pragma unroll
            for (int e = 0; e < 4; ++e) { v0[e] = sigmoidf_(v0[e] + b0[e]); v1[e] = sigmoidf_(v1[e] + b1[e]); }
            *(u32x4*)(O + gate_frag_off(u.pm, u.pn & 3, wave, ai, m, bj, lane, cbase)) = pack8(v0, v1);
        EPI_LOOP_END
    }
};
struct EpiResid {
    const float* in; float* out; int rowoff;
    __device__ __forceinline__ void operator()(f32x4 (&acc)[2][2][4][2], const Unit& u, int wr, int wc, int fr, int fq) const {
        EPI_LOOP_BEGIN
            const size_t off = (size_t)(row + rowoff) * DM + col;
            const f32x4 a0 = *(const f32x4*)(in + off), a1 = *(const f32x4*)(in + off + 4);
            *(f32x4*)(out + off) = a0 + v0; *(f32x4*)(out + off + 4) = a1 + v1;
        EPI_LOOP_END
    }
};
struct EpiStore {
    bf16_t* O; int ldc;
    __device__ __forceinline__ void operator()(f32x4 (&acc)[2][2][4][2], const Unit& u, int wr, int wc, int fr, int fq) const {
        EPI_LOOP_BEGIN
            *(u32x4*)(O + (size_t)row * ldc + col) = pack8(v0, v1);
        EPI_LOOP_END
    }
};

__device__ __forceinline__ float dpp_ror1(float x) { return __builtin_bit_cast(float, __builtin_amdgcn_mov_dpp(__builtin_bit_cast(int, x), 0x121, 0xf, 0xf, true)); }
__device__ __forceinline__ float dpp_ror2(float x) { return __builtin_bit_cast(float, __builtin_amdgcn_mov_dpp(__builtin_bit_cast(int, x), 0x122, 0xf, 0xf, true)); }

struct EpiResidNorm {
    const float* in; float* out; bf16_t* xg; const float* g; float* sumsq;
    __device__ __forceinline__ void operator()(f32x4 (&acc)[2][2][4][2], const Unit& u, int wr, int wc, int fr, int fq) const {
        const int row0 = u.pm * BM + wr * 64 + fr; const int colt = u.pn * BM + wc * 32 + 8 * fq;
#pragma unroll
        for (int ai = 0; ai < 2; ++ai)
#pragma unroll
            for (int m = 0; m < 4; ++m) { const int row = row0 + ai * HALF + m * 16; float ss = 0.f;
#pragma unroll
                for (int bj = 0; bj < 2; ++bj) { const int col = colt + bj * HALF; const size_t off = (size_t)row * DM + col;
                    const f32x4 x0 = *(const f32x4*)(in + off) + acc[ai][bj][m][0], x1 = *(const f32x4*)(in + off + 4) + acc[ai][bj][m][1];
                    *(f32x4*)(out + off) = x0; *(f32x4*)(out + off + 4) = x1;
                    const f32x4 g0 = *(const f32x4*)(g + col), g1 = *(const f32x4*)(g + col + 4);
                    *(u32x4*)(xg + off) = pack8(x0 * g0, x1 * g1);
                    ss += (x0[0] * x0[0] + x0[1] * x0[1]) + (x0[2] * x0[2] + x0[3] * x0[3]) + (x1[0] * x1[0] + x1[1] * x1[1]) + (x1[2] * x1[2] + x1[3] * x1[3]); }
                ss += __shfl_xor(ss, 16); ss += __shfl_xor(ss, 32);
                if (fq == 0) atomicAdd(sumsq + row, ss);
                if (m == 3) asm volatile("" ::: "memory"); }
    }
};

struct EpiFfn {
    bf16_t* act; float* halo; const float* cw; const float* cb; const float* sumsq;
    __device__ __forceinline__ void operator()(f32x4 (&acc)[2][2][4][2], const Unit& u, int wr, int wc, int fr, int fq) const {
        float rs[2][4];
#pragma unroll
        for (int ai = 0; ai < 2; ++ai)
#pragma unroll
            for (int m = 0; m < 4; ++m) rs[ai][m] = fast_rsq(sumsq[u.pm * BM + ai * HALF + wr * 64 + m * 16 + fr] * (1.0f / DM) + EPS);
#pragma unroll
        for (int n = 0; n < 2; ++n) {
            const int ch0 = u.pn * 128 + wc * 32 + 8 * fq + 4 * n;
            const f32x4 wg0 = *(const f32x4*)(cw + ch0), wg1 = *(const f32x4*)(cw + DFF2 + ch0), wg2 = *(const f32x4*)(cw + 2 * DFF2 + ch0), bg = *(const f32x4*)(cb + ch0);
            const f32x4 wv0 = *(const f32x4*)(cw + DFF + ch0), wv1 = *(const f32x4*)(cw + DFF2 + DFF + ch0), wv2 = *(const f32x4*)(cw + 2 * DFF2 + DFF + ch0), bv = *(const f32x4*)(cb + DFF + ch0);
#pragma unroll
            for (int ai = 0; ai < 2; ++ai) {
                const int blk = u.pm * 4 + ai * 2 + wr;
                f32x4 pg = {0.f, 0.f, 0.f, 0.f}, pv = {0.f, 0.f, 0.f, 0.f};
#pragma unroll
                for (int m = 0; m < 4; ++m) {
                    const int row = u.pm * BM + ai * HALF + wr * 64 + m * 16 + fr;
                    const f32x4 gq = acc[ai][0][m][n] * rs[ai][m], vq = acc[ai][1][m][n] * rs[ai][m];
                    f32x4 g1, g2, v1, v2;
#pragma unroll
                    for (int e = 0; e < 4; ++e) {
                        g1[e] = dpp_ror1(fr == 15 ? pg[e] : gq[e]); g2[e] = dpp_ror2(fr >= 14 ? pg[e] : gq[e]); v1[e] = dpp_ror1(fr == 15 ? pv[e] : vq[e]); v2[e] = dpp_ror2(fr >= 14 ? pv[e] : vq[e]); }
                    const f32x4 cg = bg + wg0 * g2 + wg1 * g1 + wg2 * gq, cv = bv + wv0 * v2 + wv1 * v1 + wv2 * vq;
                    {
                        u32x2 w; w.x = cvt_pk_bf16(gelu_tanh(cg[0]) * cv[0], gelu_tanh(cg[1]) * cv[1]); w.y = cvt_pk_bf16(gelu_tanh(cg[2]) * cv[2], gelu_tanh(cg[3]) * cv[3]);
                        *(u32x2*)(act + (size_t)row * DFF + ch0) = w; }
                    if (m == 0 && fr < 2) { float* hp = halo + ((size_t)blk * 4 + fr) * DFF2 + ch0; *(f32x4*)hp = gq; *(f32x4*)(hp + DFF) = vq; }
                    if (m == 3 && fr >= 14) { float* hp = halo + ((size_t)blk * 4 + fr - 12) * DFF2 + ch0; *(f32x4*)hp = gq; *(f32x4*)(hp + DFF) = vq; }
                    pg = gq; pv = vq;
                }
                asm volatile("" ::: "memory");
            }
        }
    }
};
struct EpiMerge3 {
    const bf16_t* P; bf16_t* Mb;
    __device__ __forceinline__ void operator()(f32x4 (&acc)[2][2][4][2], const Unit& u, int seg, int wr, int wc, int fr, int fq) const {
        const size_t ga = (size_t)seg * (seg == 1 ? O_DK : O_FK / 2), gb = (seg == 0 ? O_DK : O_FK); const int wave = wr * 4 + wc, lane = fq * 16 + fr;
        const int row0 = u.pm * BM + wr * 64 + fr; const int colt = u.pn * BM + wc * 32 + 8 * fq;
#pragma unroll
        for (int ai = 0; ai < 2; ++ai)
#pragma unroll
            for (int m = 0; m < 4; ++m) { const int row = row0 + ai * HALF + m * 16;
#pragma unroll
                for (int bj = 0; bj < 2; ++bj) { const int col = colt + bj * HALF;
                    const u32x4 aw = *(const u32x4*)(P + gate_frag_off(u.pm, u.pn, wave, ai, m, bj, lane, ga));
                    f32x4 s0 = {bflo(aw.x), bfhi(aw.x), bflo(aw.y), bfhi(aw.y)}, s1 = {bflo(aw.z), bfhi(aw.z), bflo(aw.w), bfhi(aw.w)};
                    if (seg != 2) { const u32x4 bw = *(const u32x4*)(P + gate_frag_off(u.pm, u.pn, wave, ai, m, bj, lane, gb));
                        const f32x4 d0 = {bflo(bw.x), bfhi(bw.x), bflo(bw.y), bfhi(bw.y)}, d1 = {bflo(bw.z), bfhi(bw.z), bflo(bw.w), bfhi(bw.w)};
#pragma unroll
                        for (int e = 0; e < 4; ++e) { s0[e] *= fast_rcp(d0[e]); s1[e] *= fast_rcp(d1[e]); } }
                    acc[ai][bj][m][0] *= s0; acc[ai][bj][m][1] *= s1;
                    if (seg == 2) *(u32x4*)(Mb + (size_t)row * DM + col) = pack8(acc[ai][bj][m][0], acc[ai][bj][m][1]); }
                if (m == 3) asm volatile("" ::: "memory"); }
    }
};
}

struct Params { const float* in[28]; float* out; unsigned char* ws; };
enum { I_X = 0, I_N1G, I_WIN, I_RCW, I_RCB, I_RGWR, I_RGBR, I_RGWI, I_RGBI, I_RGA, I_LQ1, I_LK1, I_LQ2, I_LK2, I_SUBG, I_REL, I_FOXB, I_GATEB,
       I_WBR_RNN, I_WBR_DIFF, I_WBR_FOX, I_WOUT, I_N2G, I_FUP, I_FCW, I_FCB, I_FDOWN, I_FINALG };

__constant__ unsigned char T5_BUCKET[128] = {0, 1, 2, 3, 4, 5, 6, 7, 8, 9, 10, 11, 12, 13, 14, 15, 16, 16, 16, 17, 17, 18, 18, 18, 19, 19, 19, 20, 20, 20, 20, 21, 21, 21, 21, 22, 22, 22, 22, 22, 23, 23, 23, 23, 23, 23, 24, 24, 24, 24, 24, 24, 25, 25, 25, 25, 25, 25, 25, 26, 26, 26, 26, 26, 26, 26, 26, 27, 27, 27, 27, 27, 27, 27, 27, 27, 27, 28, 28, 28, 28, 28, 28, 28, 28, 28, 28, 29, 29, 29, 29, 29, 29, 29, 29, 29, 29, 29, 29, 30, 30, 30, 30, 30, 30, 30, 30, 30, 30, 30, 30, 30, 30, 31, 31, 31, 31, 31, 31, 31, 31, 31, 31, 31, 31, 31, 31, 31};

template <bool FFN_PERM = false>
__device__ __forceinline__ void transpose_item(const float* W, int ldw, int K, bf16_t* WT, int nblk, int item, LAS float* scr, int lane) {
    const int kb = item / nblk, nb = item % nblk, k0 = 64 * kb, n0 = 32 * nb;
    const int d0 = FFN_PERM ? ((n0 < DFF) ? ((n0 >> 7) * 256 + (n0 & 127)) : ((((n0 - DFF) >> 7) * 256) + 128 + ((n0 - DFF) & 127))) : n0;
#pragma unroll 8
    for (int i = 0; i < 32; ++i) { const int kk = 2 * i + (lane >> 5); scr[kk * 33 + (lane & 31)] = W[(size_t)(k0 + kk) * ldw + n0 + (lane & 31)]; }
    asm volatile("s_waitcnt lgkmcnt(0)" ::: "memory");
    const int c = lane & 7;
#pragma unroll
    for (int j = 0; j < 4; ++j) { const int n = (lane >> 3) + 8 * j; const LAS float* s = scr + (8 * c) * 33 + n;
        u32x4 o; o.x = pk2(s[0 * 33], s[1 * 33]); o.y = pk2(s[2 * 33], s[3 * 33]); o.z = pk2(s[4 * 33], s[5 * 33]); o.w = pk2(s[6 * 33], s[7 * 33]);
        *(u32x4*)(WT + (size_t)(d0 + n) * K + k0 + 8 * c) = o; }
    asm volatile("s_waitcnt lgkmcnt(0)" ::: "memory");
}

__device__ __forceinline__ void convert_weights(const Params& P, int l, LAS unsigned char* lds, int gw, int NGW, int wid, int lane) {
    LAS float* scr = (LAS float*)(lds + wid * 8704);
    unsigned char* ws = launder_ptr(P.ws);
    constexpr int I0 = 16 * 160, I1 = 16 * 96, I2 = 16 * 32, I3 = 8 * 32, I4 = 8 * 32, I5 = 16 * 32, I6 = 16 * 176, I7 = 44 * 32, I8 = 64, I9 = 64;
    constexpr int NITEMS = I0 + I1 + I2 + I3 + I4 + I5 + I6 + I7 + I8 + I9;
    for (int it = gw; it < NITEMS; it += NGW) {
        int r = it;
        if (r < I0) { transpose_item(P.in[I_WIN] + (size_t)l * DM * NIN, NIN, DM, (bf16_t*)(ws + WS_WIN), 160, r, scr, lane); continue; } r -= I0;
        if (r < I1) { transpose_item(P.in[I_WIN] + (size_t)l * DM * NIN + 5128, NIN, DM, (bf16_t*)(ws + WS_WIN) + (size_t)5120 * DM, 96, r, scr, lane); continue; } r -= I1;
        if (r < I2) { transpose_item(P.in[I_WBR_RNN] + (size_t)l * DM * DM, DM, DM, (bf16_t*)(ws + WS_WBR_RNN), 32, r, scr, lane); continue; } r -= I2;
        if (r < I3) { transpose_item(P.in[I_WBR_DIFF] + (size_t)l * 512 * DM, DM, DM, (bf16_t*)(ws + WS_WBR_DIFF), 32, r, scr, lane); continue; } r -= I3;
        if (r < I4) { transpose_item(P.in[I_WBR_FOX] + (size_t)l * 512 * DM, DM, DM, (bf16_t*)(ws + WS_WBR_FOX), 32, r, scr, lane); continue; } r -= I4;
        if (r < I5) { transpose_item(P.in[I_WOUT] + (size_t)l * DM * DM, DM, DM, (bf16_t*)(ws + WS_WOUT), 32, r, scr, lane); continue; } r -= I5;
        if (r < I6) { transpose_item<true>(P.in[I_FUP] + (size_t)l * DM * DFF2, DFF2, DM, (bf16_t*)(ws + WS_WUP), 176, r, scr, lane); continue; } r -= I6;
        if (r < I7) { transpose_item(P.in[I_FDOWN] + (size_t)l * DFF * DM, DM, DFF, (bf16_t*)(ws + WS_WDOWN), 32, r, scr, lane); continue; } r -= I7;
        if (r < I8) { const int n = r >> 3; transpose_item(P.in[I_RGWR] + (size_t)l * 131072 + n * 16384, 128, 128, (bf16_t*)(ws + WS_RGR) + n * 16384, 4, r & 7, scr, lane); continue; } r -= I8;
        { const int n = r >> 3; transpose_item(P.in[I_RGWI] + (size_t)l * 131072 + n * 16384, 128, 128, (bf16_t*)(ws + WS_RGI) + n * 16384, 4, r & 7, scr, lane); }
    }
}

template <bool WITH_F>
__device__ __forceinline__ void rmsnorm_rows(const float* x, const float* g, bf16_t* hout, const Params& P, int l, LAS unsigned char* lds, int gw, int NGW, int lane) {
    LAS f32x4* wf = (LAS f32x4*)(lds + 73728);
    if (WITH_F) {
        const float* win = P.in[I_WIN] + (size_t)l * DM * NIN;
        for (int idx = threadIdx.x; idx < 8192; idx += blockDim.x) { const int k = idx >> 3, jj = idx & 7;
            const float v = g[k] * win[(size_t)k * NIN + 5120 + jj];
            const int ln = (k & 255) >> 2, e = k & 3, j = k >> 8, half = jj >> 2;
            ((LAS float*)wf)[((((j * 4 + e) * 2 + half) * 64 + ln) << 2) + (jj & 3)] = v; }
        __syncthreads();
    }
    f32x4 gv[4];
#pragma unroll
    for (int j = 0; j < 4; ++j) gv[j] = ((const f32x4*)g)[lane + 64 * j];
    const float bfv = WITH_F ? P.in[I_FOXB][l * 8 + (lane & 7)] : 0.f;
    for (int m = gw; m < MTOK; m += NGW) {
        const f32x4* xr = (const f32x4*)(x + (size_t)m * DM) + lane;
        f32x4 v[4]; float ss = 0.f;
#pragma unroll
        for (int j = 0; j < 4; ++j) { v[j] = xr[64 * j]; ss += (v[j].x * v[j].x + v[j].y * v[j].y) + (v[j].z * v[j].z + v[j].w * v[j].w); }
        const float rstd = fast_rsq(wave_sum(ss) * (1.0f / DM) + EPS);
        unsigned long long* o8 = (unsigned long long*)(hout + (size_t)m * DM) + lane;
#pragma unroll
        for (int j = 0; j < 4; ++j) { const f32x4 hv = v[j] * rstd * gv[j];
            o8[64 * j] = (unsigned long long)pk2(hv.x, hv.y) | ((unsigned long long)pk2(hv.z, hv.w) << 32); }
        if (WITH_F) {
            float a[8];
#pragma unroll
            for (int q = 0; q < 8; ++q) a[q] = 0.f;
#pragma unroll
            for (int j = 0; j < 4; ++j)
#pragma unroll
                for (int e = 0; e < 4; ++e) { const f32x4 w0 = wf[((j * 4 + e) * 2 + 0) * 64 + lane], w1 = wf[((j * 4 + e) * 2 + 1) * 64 + lane]; const float xv = v[j][e];
                    a[0] += xv * w0.x; a[1] += xv * w0.y; a[2] += xv * w0.z; a[3] += xv * w0.w; a[4] += xv * w1.x; a[5] += xv * w1.y; a[6] += xv * w1.z; a[7] += xv * w1.w; }
            float mine = 0.f;
#pragma unroll
            for (int q = 0; q < 8; ++q) { const float s = wave_sum(a[q]); if ((lane & 7) == q) mine = s; }
            if (lane < 8) { const float z = mine * rstd + bfv; const float lf = -(fmaxf(-z, 0.f) + log1p_small(fast_exp2(-fabsf(z) * LOG2E)));
                ((float*)(launder_ptr(P.ws) + WS_LOGF))[(size_t)m * 8 + lane] = lf; }
        }
    }
}

__device__ __forceinline__ void cumsum_logf(const Params& P, int b, int wid, int lane) {
    unsigned char* ws_ = launder_ptr(P.ws);
    const float* lf = (const float*)(ws_ + WS_LOGF) + (size_t)b * SEQ * 8 + wid;
    float* c = (float*)(ws_ + WS_C) + (size_t)b * SEQ * 8 + wid;
    float v[32]; float s = 0.f;
#pragma unroll
    for (int i = 0; i < 32; ++i) { s += lf[(size_t)(lane * 32 + i) * 8]; v[i] = s; }
    float inc = s;
#pragma unroll
    for (int o = 1; o < 64; o <<= 1) { const float t = __shfl_up(inc, o); if (lane >= o) inc += t; }
    const float excl = inc - s;
#pragma unroll
    for (int i = 0; i < 32; ++i) c[(size_t)(lane * 32 + i) * 8] = (excl + v[i]) * LOG2E;
}

__device__ __forceinline__ void rglru_unit(const Params& P, int l, int unit, LAS unsigned char* lds, bool dry = false) {
    const int tid = launder_tid(), lane = tid & 63, wid = __builtin_amdgcn_readfirstlane(tid >> 6), r32 = lane & 31, hi = lane >> 5;
    const int j = unit & 1, n = (unit >> 1) & 7, b = unit >> 4;
    unsigned char* ws_ = launder_ptr(P.ws);
    const int tb = wid & 3, cb = wid >> 2;
    const int dch = 64 * j + 32 * cb + r32, dglob = 128 * n + dch;
    bf16_t* proj = (bf16_t*)(ws_ + WS_P);
    LAS unsigned char* WB = lds + 104448;
    {
#pragma unroll
      for (int i = 0; i < 4; ++i) { const int idx = tid + 512 * i, gate = idx >> 10, rem = idx & 1023, d = rem >> 4, ch = rem & 15;
          const bf16_t* srcw = (const bf16_t*)(ws_ + (gate ? WS_RGI : WS_RGR)) + n * 16384 + (64 * j + d) * 128 + ch * 8;
          *(LAS u32x4*)(WB + (gate * 64 + d) * 272 + ch * 16) = *(const u32x4*)srcw; } }
    const float br = P.in[I_RGBR][l * DM + dglob], bi = P.in[I_RGBI][l * DM + dglob];
    const float ap_ = P.in[I_RGA][l * DM + dglob]; const float sp8 = 8.0f * (fmaxf(-ap_, 0.f) + log1p_small(fast_exp2(-fabsf(ap_) * LOG2E)));
    const int cc = tid & 15, rg = tid >> 4;
    float cw[4][8], cbias[8];
#pragma unroll
    for (int e = 0; e < 8; ++e) { cbias[e] = P.in[I_RCB][l * DM + 128 * n + 8 * cc + e];
#pragma unroll
        for (int k = 0; k < 4; ++k) cw[k][e] = P.in[I_RCW][(l * 4 + k) * DM + 128 * n + 8 * cc + e]; }
    LAS unsigned char* xc = lds;
    LAS float* Ab = (LAS float*)(lds + 34816);
    LAS float* Ub = (LAS float*)(lds + 67584);
    LAS f32x2* seg = (LAS f32x2*)(lds + 100352);
    float carry = 0.f;
    const size_t rowb = (size_t)b * SEQ;
    u32x4 xw[7];
#define RG_XLOAD(T0) do { _Pragma("unroll") for (int k = 0; k < 7; ++k) { const int t = (T0) + 4 * rg - 3 + k; xw[k] = (u32x4){0u, 0u, 0u, 0u}; \
        if (t >= 0) xw[k] = *(const u32x4*)(proj + O_XR + (rowb + t) * XP + 128 * n + 8 * cc); } } while (0)
    RG_XLOAD(0);
    for (int tile = 0; tile < SEQ / 128; ++tile) {
        const int t0 = tile * 128;
        {
            float xv[7][8];
#pragma unroll
            for (int k = 0; k < 7; ++k) { const u32x4 w = xw[k];
                xv[k][0] = bflo(w.x); xv[k][1] = bfhi(w.x); xv[k][2] = bflo(w.y); xv[k][3] = bfhi(w.y); xv[k][4] = bflo(w.z); xv[k][5] = bfhi(w.z); xv[k][6] = bflo(w.w); xv[k][7] = bfhi(w.w); }
#pragma unroll
            for (int i = 0; i < 4; ++i) { float o[8];
#pragma unroll
                for (int e = 0; e < 8; ++e) o[e] = cbias[e] + cw[0][e] * xv[i][e] + cw[1][e] * xv[i + 1][e] + cw[2][e] * xv[i + 2][e] + cw[3][e] * xv[i + 3][e];
                u32x4 w; w.x = pk2(o[0], o[1]); w.y = pk2(o[2], o[3]); w.z = pk2(o[4], o[5]); w.w = pk2(o[6], o[7]);
                *(LAS u32x4*)(xc + (4 * rg + i) * 272 + cc * 16) = w; }
        }
        if (tile + 1 < SEQ / 128) RG_XLOAD(t0 + 128);
        const int sc = lane, ss = wid;
        bf16_t* gp = proj + O_GR + (rowb + t0 + 16 * ss) * XP + 128 * n + 64 * j + sc;
        unsigned short gq[16];
#pragma unroll
        for (int k = 0; k < 16; ++k) gq[k] = gp[(size_t)k * XP];
        __syncthreads();
        f32x16 accr = {}, acci = {};
#pragma unroll
        for (int s = 0; s < 8; ++s) { const bf16x8 a = *(const LAS bf16x8*)(xc + (32 * tb + r32) * 272 + (16 * s + 8 * hi) * 2);
            const bf16x8 wr_ = *(const LAS bf16x8*)(WB + (32 * cb + r32) * 272 + (16 * s + 8 * hi) * 2), wi_ = *(const LAS bf16x8*)(WB + (64 + 32 * cb + r32) * 272 + (16 * s + 8 * hi) * 2);
            accr = __builtin_amdgcn_mfma_f32_32x32x16_bf16(a, wr_, accr, 0, 0, 0); acci = __builtin_amdgcn_mfma_f32_32x32x16_bf16(a, wi_, acci, 0, 0, 0); }
#pragma unroll
        for (int r = 0; r < 16; ++r) { const int tok = 32 * tb + crow(r, hi);
            const float rr = sigmoidf_(accr[r] + br), ii = sigmoidf_(acci[r] + bi);
            const float la = -rr * sp8; const float a = fast_exp2(la * LOG2E);
            const float x2 = 2.0f * la;
            const float em = -x2 * (1.0f + x2 * (0.5f + x2 * (0.16666667f + x2 * (0.041666668f + x2 * (0.0083333338f + x2 * 0.0013888889f)))));
            const float mult = __builtin_sqrtf(fmaxf(em, 0.f));
            const float xcv = bf2f(*(const LAS unsigned short*)(xc + tok * 272 + dch * 2));
            Ab[tok * 64 + 32 * cb + r32] = a; Ub[tok * 64 + 32 * cb + r32] = mult * ii * xcv; }
        __syncthreads();
        { const int c = sc, s = ss;
          float As = 1.f, Hs = 0.f;
#pragma unroll
          for (int k = 0; k < 16; ++k) { const float a = Ab[(16 * s + k) * 64 + c], u = Ub[(16 * s + k) * 64 + c]; Hs = a * Hs + u; As *= a; }
          seg[s * 64 + c] = (f32x2){As, Hs};
          __syncthreads();
          float hin = carry, hn = carry;
#pragma unroll
          for (int s2 = 0; s2 < 8; ++s2) { if (s2 == s) hin = hn; const f32x2 sg = seg[s2 * 64 + c]; hn = sg.x * hn + sg.y; }
          carry = hn;
          float h = hin;
#pragma unroll
          for (int k = 0; k < 16; ++k) { const float a = Ab[(16 * s + k) * 64 + c], u = Ub[(16 * s + k) * 64 + c]; h = a * h + u;
              const float gg = bf2f(gq[k]); gp[(size_t)k * XP] = (bf16_t)f2bf(dry ? gg : gg * h); }
        }
    }
#undef RG_XLOAD
    __syncthreads();
}

__device__ __forceinline__ float half_max(float v) { auto rr = __builtin_amdgcn_permlane32_swap(__float_as_uint(v), __float_as_uint(v), false, false); return fmaxf(__uint_as_float(rr[0]), __uint_as_float(rr[1])); }
__device__ __forceinline__ float half_sum(float v) { auto rr = __builtin_amdgcn_permlane32_swap(__float_as_uint(v), __float_as_uint(v), false, false); return __uint_as_float(rr[0]) + __uint_as_float(rr[1]); }

__device__ __forceinline__ void attn_qk(f32x16& p0, f32x16& p1, const LAS unsigned char* Kt, int kstride, const bf16x8 (&qf)[4], int r32, int hi) {
#pragma unroll
    for (int d0 = 0; d0 < 4; ++d0) {
        const bf16x8 k0 = *(const LAS bf16x8*)(Kt + r32 * kstride + d0 * 32 + hi * 16);
        const bf16x8 k1 = *(const LAS bf16x8*)(Kt + (r32 + 32) * kstride + d0 * 32 + hi * 16);
        p0 = __builtin_amdgcn_mfma_f32_32x32x16_bf16(k0, qf[d0], p0, 0, 0, 0);
        p1 = __builtin_amdgcn_mfma_f32_32x32x16_bf16(k1, qf[d0], p1, 0, 0, 0);
    }
}

template <int NDT, int VSTR>
__device__ __forceinline__ void attn_sm_pv(f32x16& p0, f32x16& p1, f32x16& n0, f32x16& n1, bool has_next, const LAS unsigned char* Vt,
                                           f32x16 (&o)[NDT], float& mref, float& lrun, bool first, bool domask, int qrel, LAS float* wsf, int r32, int hi) {
    if (domask) {
#pragma unroll
        for (int r = 0; r < 16; ++r) { const int kv = crow(r, hi); if (kv > qrel) p0[r] = -INFINITY; if (kv + 32 > qrel) p1[r] = -INFINITY; }
    }
    float ra = fmaxf(fmaxf(p0[0], p0[1]), p1[0]), rb = fmaxf(fmaxf(p0[2], p0[3]), p1[1]);
    ra = fmaxf(fmaxf(ra, p1[2]), p1[3]);
#pragma unroll
    for (int r = 4; r < 16; r += 4) { ra = fmaxf(fmaxf(ra, p0[r]), p0[r + 1]); rb = fmaxf(fmaxf(rb, p0[r + 2]), p0[r + 3]); ra = fmaxf(fmaxf(ra, p1[r]), p1[r + 1]); rb = fmaxf(fmaxf(rb, p1[r + 2]), p1[r + 3]); }
    const float rm = half_max(fmaxf(ra, rb));
    if (first || __any(rm > 8.0f)) {
        const float dl = first ? rm : fmaxf(rm, 0.f);
        mref += dl;
#pragma unroll
        for (int r = 0; r < 16; ++r) { p0[r] -= dl; p1[r] -= dl; }
        if (has_next) {
#pragma unroll
            for (int r = 0; r < 16; ++r) { n0[r] -= dl; n1[r] -= dl; } }
        if (!first) {
            const float alpha = fast_exp2(-dl);
            lrun *= alpha;
            if (hi == 0) wsf[r32] = alpha;
            asm volatile("s_waitcnt lgkmcnt(0)" ::: "memory");
#pragma unroll
            for (int jj = 0; jj < 4; ++jj) { const f32x4 al = *(const LAS f32x4*)(wsf + 8 * jj + 4 * hi);
#pragma unroll
                for (int d = 0; d < NDT; ++d) { o[d][4 * jj + 0] *= al.x; o[d][4 * jj + 1] *= al.y; o[d][4 * jj + 2] *= al.z; o[d][4 * jj + 3] *= al.w; } }
            asm volatile("s_waitcnt lgkmcnt(0)" ::: "memory");
        }
    }
    constexpr int PRE = (NDT == 2) ? 4 : 1;
    const int lane_ = hi * 32 + r32;
    const LAS unsigned char* vb = Vt + (4 * hi + ((lane_ & 15) >> 2)) * VSTR + (16 * ((lane_ >> 4) & 1) + 4 * (lane_ & 3)) * 2;
#define VFRAG(s, d) ({ const s16x4 lo_ = __builtin_bit_cast(s16x4, __builtin_amdgcn_ds_read_tr16_b64_v4i16((LAS s16x4*)(vb + (16 * (s)) * VSTR + 64 * (d)))); \
                       const s16x4 hh_ = __builtin_bit_cast(s16x4, __builtin_amdgcn_ds_read_tr16_b64_v4i16((LAS s16x4*)(vb + (16 * (s) + 8) * VSTR + 64 * (d)))); \
                       (bf16x8){lo_[0], lo_[1], lo_[2], lo_[3], hh_[0], hh_[1], hh_[2], hh_[3]}; })
    bf16x8 vpre[PRE][NDT];
#pragma unroll
    for (int s = 0; s < PRE; ++s)
#pragma unroll
        for (int d = 0; d < NDT; ++d) vpre[s][d] = VFRAG(s, d);
    float rs0 = 0.f, rs1 = 0.f;
#pragma unroll
    for (int r = 0; r < 16; ++r) { p0[r] = fast_exp2(p0[r]); p1[r] = fast_exp2(p1[r]); rs0 += p0[r]; rs1 += p1[r]; }
    lrun += rs0 + rs1;
    bf16x8 pa[4];
#pragma unroll
    for (int s = 0; s < 2; ++s) {
        u32x4 w0, w1;
        w0.x = cvt_pk_bf16(p0[8 * s + 0], p0[8 * s + 1]); w0.y = cvt_pk_bf16(p0[8 * s + 2], p0[8 * s + 3]); w0.z = cvt_pk_bf16(p0[8 * s + 4], p0[8 * s + 5]); w0.w = cvt_pk_bf16(p0[8 * s + 6], p0[8 * s + 7]);
        w1.x = cvt_pk_bf16(p1[8 * s + 0], p1[8 * s + 1]); w1.y = cvt_pk_bf16(p1[8 * s + 2], p1[8 * s + 3]); w1.z = cvt_pk_bf16(p1[8 * s + 4], p1[8 * s + 5]); w1.w = cvt_pk_bf16(p1[8 * s + 6], p1[8 * s + 7]);
        pa[s] = __builtin_bit_cast(bf16x8, w0); pa[2 + s] = __builtin_bit_cast(bf16x8, w1);
    }
#pragma unroll
    for (int s = 0; s < 4; ++s) {
        bf16x8 vw[NDT];
#pragma unroll
        for (int d = 0; d < NDT; ++d) { if (s < PRE) vw[d] = vpre[s < PRE ? s : 0][d]; else vw[d] = VFRAG(s, d); }
#pragma unroll
        for (int d = 0; d < NDT; ++d) o[d] = __builtin_amdgcn_mfma_f32_32x32x16_bf16(pa[s], vw[d], o[d], 0, 0, 0);
    }
#undef VFRAG
}

#define SBAR_() __builtin_amdgcn_sched_barrier(0)
__device__ __forceinline__ float rowmax32(const f32x16& a, const f32x16& b) {
    float ra = fmaxf(fmaxf(a[0], a[1]), b[0]), rb = fmaxf(fmaxf(a[2], a[3]), b[1]);
    ra = fmaxf(fmaxf(ra, b[2]), b[3]);
#pragma unroll
    for (int r = 4; r < 16; r += 4) { ra = fmaxf(fmaxf(ra, a[r]), a[r + 1]); rb = fmaxf(fmaxf(rb, a[r + 2]), a[r + 3]); ra = fmaxf(fmaxf(ra, b[r]), b[r + 1]); rb = fmaxf(fmaxf(rb, b[r + 2]), b[r + 3]); }
    return half_max(fmaxf(ra, rb));
}
__device__ __forceinline__ void fox_steady_step(f32x16& s0, f32x16& s1, f32x16& n0, f32x16& n1, const LAS unsigned char* kb, int coff, const LAS unsigned char* Vt,
                                                const bf16x8 (&qf)[4], f32x16 (&o)[2], float& mref, float& lrun, float cq, LAS float* wsf, int r32, int hi, float& rmc) {
    const float rm = rmc;
    if (__any(rm > 8.0f)) {
        const float dl = fmaxf(rm, 0.f);
        mref += dl;
#pragma unroll
        for (int r = 0; r < 16; ++r) { s0[r] -= dl; s1[r] -= dl; }
        const float alpha = fast_exp2(-dl);
        lrun *= alpha;
        if (hi == 0) wsf[r32] = alpha;
        asm volatile("s_waitcnt lgkmcnt(0)" ::: "memory");
#pragma unroll
        for (int jj = 0; jj < 4; ++jj) { const f32x4 al = *(const LAS f32x4*)(wsf + 8 * jj + 4 * hi);
#pragma unroll
            for (int d = 0; d < 2; ++d) { o[d][4 * jj + 0] *= al.x; o[d][4 * jj + 1] *= al.y; o[d][4 * jj + 2] *= al.z; o[d][4 * jj + 3] *= al.w; } }
        asm volatile("s_waitcnt lgkmcnt(0)" ::: "memory");
    }
    bf16x8 kf[8]; f32x4 ck4[8]; bf16x8 vf[4][2];
#pragma unroll
    for (int d0 = 0; d0 < 4; ++d0) { kf[2 * d0] = *(const LAS bf16x8*)(kb + r32 * 144 + d0 * 32 + hi * 16); kf[2 * d0 + 1] = *(const LAS bf16x8*)(kb + (r32 + 32) * 144 + d0 * 32 + hi * 16); }
#pragma unroll
    for (int jj = 0; jj < 4; ++jj) { ck4[jj] = *(const LAS f32x4*)(kb + coff + (8 * jj + 4 * hi) * 4); ck4[4 + jj] = *(const LAS f32x4*)(kb + coff + (32 + 8 * jj + 4 * hi) * 4); }
    { const int lane_ = hi * 32 + r32;
      const LAS unsigned char* vb = Vt + (4 * hi + ((lane_ & 15) >> 2)) * 192 + (16 * ((lane_ >> 4) & 1) + 4 * (lane_ & 3)) * 2;
#pragma unroll
      for (int s = 0; s < 4; ++s)
#pragma unroll
          for (int d = 0; d < 2; ++d) {
              const s16x4 lo_ = __builtin_bit_cast(s16x4, __builtin_amdgcn_ds_read_tr16_b64_v4i16((LAS s16x4*)(vb + (16 * s) * 192 + 64 * d)));
              const s16x4 hh_ = __builtin_bit_cast(s16x4, __builtin_amdgcn_ds_read_tr16_b64_v4i16((LAS s16x4*)(vb + (16 * s + 8) * 192 + 64 * d)));
              vf[s][d] = (bf16x8){lo_[0], lo_[1], lo_[2], lo_[3], hh_[0], hh_[1], hh_[2], hh_[3]}; } }
    { const float cqm = cq - mref;
#pragma unroll
      for (int jj = 0; jj < 4; ++jj)
#pragma unroll
          for (int e = 0; e < 4; ++e) { n0[4 * jj + e] = cqm - ck4[jj][e]; n1[4 * jj + e] = cqm - ck4[4 + jj][e]; } }
    SBAR_();
    float rs = 0.f; u32x4 w0, w1, w2, w3;
#define EXPN_(P, B, N) do { _Pragma("unroll") for (int e_ = 0; e_ < (N); ++e_) { P[(B) + e_] = fast_exp2(P[(B) + e_]); rs += P[(B) + e_]; } } while (0)
    n0 = __builtin_amdgcn_mfma_f32_32x32x16_bf16(kf[0], qf[0], n0, 0, 0, 0); EXPN_(s0, 0, 3); SBAR_();
    n1 = __builtin_amdgcn_mfma_f32_32x32x16_bf16(kf[1], qf[0], n1, 0, 0, 0); EXPN_(s0, 3, 3); w0.x = cvt_pk_bf16(s0[0], s0[1]); w0.y = cvt_pk_bf16(s0[2], s0[3]); SBAR_();
    n0 = __builtin_amdgcn_mfma_f32_32x32x16_bf16(kf[2], qf[1], n0, 0, 0, 0); EXPN_(s0, 6, 3); w0.z = cvt_pk_bf16(s0[4], s0[5]); w0.w = cvt_pk_bf16(s0[6], s0[7]); SBAR_();
    n1 = __builtin_amdgcn_mfma_f32_32x32x16_bf16(kf[3], qf[1], n1, 0, 0, 0); EXPN_(s0, 9, 3); w1.x = cvt_pk_bf16(s0[8], s0[9]); w1.y = cvt_pk_bf16(s0[10], s0[11]); SBAR_();
    n0 = __builtin_amdgcn_mfma_f32_32x32x16_bf16(kf[4], qf[2], n0, 0, 0, 0); EXPN_(s0, 12, 4); w1.z = cvt_pk_bf16(s0[12], s0[13]); w1.w = cvt_pk_bf16(s0[14], s0[15]); SBAR_();
    n1 = __builtin_amdgcn_mfma_f32_32x32x16_bf16(kf[5], qf[2], n1, 0, 0, 0); EXPN_(s1, 0, 3); SBAR_();
    n0 = __builtin_amdgcn_mfma_f32_32x32x16_bf16(kf[6], qf[3], n0, 0, 0, 0); EXPN_(s1, 3, 3); w2.x = cvt_pk_bf16(s1[0], s1[1]); w2.y = cvt_pk_bf16(s1[2], s1[3]); SBAR_();
    n1 = __builtin_amdgcn_mfma_f32_32x32x16_bf16(kf[7], qf[3], n1, 0, 0, 0); EXPN_(s1, 6, 2); w2.z = cvt_pk_bf16(s1[4], s1[5]); w2.w = cvt_pk_bf16(s1[6], s1[7]); SBAR_();
    const bf16x8 pa0 = __builtin_bit_cast(bf16x8, w0), pa1 = __builtin_bit_cast(bf16x8, w1), pa2 = __builtin_bit_cast(bf16x8, w2);
    float ra = fmaxf(fmaxf(n0[0], n0[1]), n1[0]), rb = fmaxf(fmaxf(n0[2], n0[3]), n1[1]);
    o[0] = __builtin_amdgcn_mfma_f32_32x32x16_bf16(pa0, vf[0][0], o[0], 0, 0, 0); EXPN_(s1, 8, 2); ra = fmaxf(fmaxf(ra, n1[2]), n1[3]); SBAR_();
    o[1] = __builtin_amdgcn_mfma_f32_32x32x16_bf16(pa0, vf[0][1], o[1], 0, 0, 0); EXPN_(s1, 10, 2); w3.x = cvt_pk_bf16(s1[8], s1[9]); rb = fmaxf(fmaxf(rb, n0[4]), n0[5]); SBAR_();
    o[0] = __builtin_amdgcn_mfma_f32_32x32x16_bf16(pa1, vf[1][0], o[0], 0, 0, 0); EXPN_(s1, 12, 2); w3.y = cvt_pk_bf16(s1[10], s1[11]); ra = fmaxf(fmaxf(ra, n0[6]), n0[7]); SBAR_();
    o[1] = __builtin_amdgcn_mfma_f32_32x32x16_bf16(pa1, vf[1][1], o[1], 0, 0, 0); EXPN_(s1, 14, 2); w3.z = cvt_pk_bf16(s1[12], s1[13]); rb = fmaxf(fmaxf(rb, n1[4]), n1[5]); SBAR_();
    o[0] = __builtin_amdgcn_mfma_f32_32x32x16_bf16(pa2, vf[2][0], o[0], 0, 0, 0); w3.w = cvt_pk_bf16(s1[14], s1[15]); ra = fmaxf(fmaxf(ra, n1[6]), n1[7]); rb = fmaxf(fmaxf(rb, n0[8]), n0[9]); SBAR_();
    o[1] = __builtin_amdgcn_mfma_f32_32x32x16_bf16(pa2, vf[2][1], o[1], 0, 0, 0); ra = fmaxf(fmaxf(ra, n0[10]), n0[11]); rb = fmaxf(fmaxf(rb, n1[8]), n1[9]); ra = fmaxf(fmaxf(ra, n1[10]), n1[11]); rb = fmaxf(fmaxf(rb, n0[12]), n0[13]); SBAR_();
    const bf16x8 pa3 = __builtin_bit_cast(bf16x8, w3);
    lrun += rs;
    o[0] = __builtin_amdgcn_mfma_f32_32x32x16_bf16(pa3, vf[3][0], o[0], 0, 0, 0); ra = fmaxf(fmaxf(ra, n0[14]), n0[15]); rb = fmaxf(fmaxf(rb, n1[12]), n1[13]); ra = fmaxf(fmaxf(ra, n1[14]), n1[15]); SBAR_();
    o[1] = __builtin_amdgcn_mfma_f32_32x32x16_bf16(pa3, vf[3][1], o[1], 0, 0, 0);
#undef EXPN_
    rmc = half_max(fmaxf(ra, rb));
}

__device__ __forceinline__ void fox_unit(const Params& P, int b, int h, int qb, LAS unsigned char* lds, bool dry = false) {
    unsigned char* ws_ = launder_ptr(P.ws);
    const int tid = launder_tid(), lane = tid & 63, wid = __builtin_amdgcn_readfirstlane(tid >> 6), r32 = lane & 31, hi = lane >> 5;
    bf16_t* proj = (bf16_t*)(ws_ + WS_P);
    const float* cbuf = (const float*)(ws_ + WS_C);
    const size_t rowb = (size_t)b * SEQ; const int q0 = qb * 256;
    constexpr int BUFB = 21760, KOFF = 0, VOFF = 9216, COFF = 21504, FVS = 192;
    LAS float* wsf = (LAS float*)(lds + 2 * BUFB) + wid * 64;
    bf16x8 qf[4];
    { const bf16_t* Qw = proj + O_FQ + (rowb + q0 + wid * 32 + r32) * QP + h * 64;
#pragma unroll
      for (int d0 = 0; d0 < 4; ++d0) qf[d0] = *(const bf16x8*)(Qw + d0 * 16 + hi * 8); }
    const float cq = cbuf[(rowb + q0 + wid * 32 + r32) * 8 + h];
    f32x16 o[2]; o[0] = f32x16{}; o[1] = f32x16{};
    float mref = 0.f, lrun = 0.f;
    const int NT = 4 * (qb + 1);
    const int srow = tid >> 3, sch = tid & 7;
    u32x4 kreg, vreg; float creg = 0.f;
    const bf16_t* sbase = proj + (rowb + srow) * QP + h * 64 + sch * 8;
#define FOX_GLOADK(t) do { kreg = *(const u32x4*)(sbase + O_FK + (size_t)(64 * (t)) * QP); if (tid < 64) creg = cbuf[(rowb + 64 * (t) + tid) * 8 + h]; } while (0)
#define FOX_GLOADV(t) do { vreg = *(const u32x4*)(sbase + O_FV + (size_t)(64 * (t)) * QP); } while (0)
#define FOX_LSTOREK(buf) do { LAS unsigned char* bb_ = lds + (buf) * BUFB; *(LAS u32x4*)(bb_ + KOFF + srow * 144 + sch * 16) = kreg; if (tid < 64) *(LAS float*)(bb_ + COFF + tid * 4) = creg; } while (0)
#define FOX_LSTOREV(buf) (*(LAS u32x4*)(lds + (buf) * BUFB + VOFF + srow * FVS + sch * 16) = vreg)
#define FOX_INIT(P0, P1, buf) do { const LAS unsigned char* bb_ = lds + (buf) * BUFB; const float cqm = cq - mref; \
        _Pragma("unroll") for (int jj = 0; jj < 4; ++jj) { const f32x4 c0 = *(const LAS f32x4*)(bb_ + COFF + (8 * jj + 4 * hi) * 4), c1 = *(const LAS f32x4*)(bb_ + COFF + (32 + 8 * jj + 4 * hi) * 4); \
            _Pragma("unroll") for (int e = 0; e < 4; ++e) { P0[4 * jj + e] = cqm - c0[e]; P1[4 * jj + e] = cqm - c1[e]; } } } while (0)
    FOX_GLOADK(0); FOX_GLOADV(0); FOX_LSTOREK(0); FOX_LSTOREV(0);
    FOX_GLOADK(1); FOX_LSTOREK(1);
    __syncthreads();
    f32x16 s0, s1, n0 = {}, n1 = {};
    FOX_INIT(s0, s1, 0); attn_qk(s0, s1, lds + KOFF, 144, qf, r32, hi);
#define FOX_ITER(t, S0, S1, N0, N1) do { \
        if ((t) + 2 < NT) FOX_GLOADK((t) + 2); \
        if ((t) + 1 < NT) FOX_GLOADV((t) + 1); \
        const int jb = (t) - (NT - 4); \
        const bool active = (jb < 0) || (jb <= (wid >> 1)); \
        const bool act_next = ((t) + 1 < NT) && ((jb + 1 < 0) || (jb + 1 <= (wid >> 1))); \
        if (act_next) { FOX_INIT(N0, N1, ((t) + 1) & 1); attn_qk(N0, N1, lds + (((t) + 1) & 1) * BUFB + KOFF, 144, qf, r32, hi); } \
        if (active) { const bool domask = (jb >= 0) && (64 * jb + 63 > 32 * wid); \
            attn_sm_pv<2, 192>(S0, S1, N0, N1, act_next, lds + ((t) & 1) * BUFB + VOFF, o, mref, lrun, (t) == 0, domask, q0 + wid * 32 + r32 - 64 * (t), wsf, r32, hi); } \
        if ((t) + 2 < NT) FOX_LSTOREK((t) & 1); \
        if ((t) + 1 < NT) FOX_LSTOREV(((t) + 1) & 1); \
        __syncthreads(); } while (0)
#define FOX_STEADY(t, S0, S1, N0, N1) do { \
        FOX_GLOADK((t) + 2); FOX_GLOADV((t) + 1); \
        fox_steady_step(S0, S1, N0, N1, lds + (((t) + 1) & 1) * BUFB + KOFF, COFF - KOFF, lds + ((t) & 1) * BUFB + VOFF, qf, o, mref, lrun, cq, wsf, r32, hi, rmc); \
        FOX_LSTOREK((t) & 1); FOX_LSTOREV(((t) + 1) & 1); \
        __syncthreads(); } while (0)
    FOX_ITER(0, s0, s1, n0, n1);
    int t = 1;
    float rmc = 0.f;
    if (t + 1 <= NT - 6) rmc = rowmax32(n0, n1);
    for (; t + 1 <= NT - 6; t += 2) { FOX_STEADY(t, n0, n1, s0, s1); FOX_STEADY(t + 1, s0, s1, n0, n1); }
    for (; t + 1 < NT; t += 2) { FOX_ITER(t, n0, n1, s0, s1); FOX_ITER(t + 1, s0, s1, n0, n1); }
    FOX_ITER(NT - 1, n0, n1, s0, s1);
#undef FOX_STEADY
#undef FOX_ITER
#undef FOX_GLOADK
#undef FOX_GLOADV
#undef FOX_LSTOREK
#undef FOX_LSTOREV
#undef FOX_INIT
    const float lt = half_sum(lrun);
    if (hi == 0) wsf[r32] = fast_rcp(lt);
    asm volatile("s_waitcnt lgkmcnt(0)" ::: "memory");
    bf16_t* Ow = proj + O_FQ + (rowb + q0 + wid * 32) * QP + h * 64;
#pragma unroll
    for (int r = 0; r < 16; ++r) { const int q = crow(r, hi); const float il = wsf[q];
#pragma unroll
        for (int d = 0; d < 2; ++d) if (!dry || o[d][r] == 1.2345e30f) Ow[(size_t)q * QP + 32 * d + r32] = (bf16_t)f2bf(o[d][r] * il); }
    __syncthreads();
}

__device__ __forceinline__ void diff_steady_step(f32x16& s0, f32x16& s1, f32x16& n0, f32x16& n1, const LAS unsigned char* kb, const LAS unsigned char* Vt, const LAS unsigned char* qlds,
                                                 f32x16 (&o)[4], float& mref, float& lrun, float b31, LAS float* wsf, int r32, int hi, float& rmc, const bf16_t* vsrc, size_t vstep, u32x4 (&vreg)[2]) {
    const float rm = rmc;
    if (__any(rm > 8.0f)) {
        const float dl = fmaxf(rm, 0.f);
        mref += dl;
#pragma unroll
        for (int r = 0; r < 16; ++r) { s0[r] -= dl; s1[r] -= dl; }
        const float alpha = fast_exp2(-dl);
        lrun *= alpha;
        if (hi == 0) wsf[r32] = alpha;
        asm volatile("s_waitcnt lgkmcnt(0)" ::: "memory");
#pragma unroll
        for (int jj = 0; jj < 4; ++jj) { const f32x4 al = *(const LAS f32x4*)(wsf + 8 * jj + 4 * hi);
#pragma unroll
            for (int d = 0; d < 4; ++d) { o[d][4 * jj + 0] *= al.x; o[d][4 * jj + 1] *= al.y; o[d][4 * jj + 2] *= al.z; o[d][4 * jj + 3] *= al.w; } }
        asm volatile("s_waitcnt lgkmcnt(0)" ::: "memory");
    }
    const int lane_ = hi * 32 + r32;
    const LAS unsigned char* vb = Vt + (4 * hi + ((lane_ & 15) >> 2)) * 320 + (16 * ((lane_ >> 4) & 1) + 4 * (lane_ & 3)) * 2;
#define DVF_(s, d) ({ const s16x4 lo_ = __builtin_bit_cast(s16x4, __builtin_amdgcn_ds_read_tr16_b64_v4i16((LAS s16x4*)(vb + (16 * (s)) * 320 + 64 * (d)))); \
                      const s16x4 hh_ = __builtin_bit_cast(s16x4, __builtin_amdgcn_ds_read_tr16_b64_v4i16((LAS s16x4*)(vb + (16 * (s) + 8) * 320 + 64 * (d)))); \
                      (bf16x8){lo_[0], lo_[1], lo_[2], lo_[3], hh_[0], hh_[1], hh_[2], hh_[3]}; })
    bf16x8 ka[3], kc[3], va[4];
#define DKF_(dst, d0) do { dst[0] = *(const LAS bf16x8*)(kb + r32 * 272 + (d0) * 32 + hi * 16); dst[1] = *(const LAS bf16x8*)(kb + (r32 + 32) * 272 + (d0) * 32 + hi * 16); dst[2] = *(const LAS bf16x8*)(qlds + (d0) * 32); } while (0)
    DKF_(ka, 0); DKF_(kc, 1);
    { const float v_ = b31 - mref;
#pragma unroll
      for (int r = 0; r < 16; ++r) { n0[r] = v_; n1[r] = v_; } }
    SBAR_();
    float rs = 0.f; u32x4 w0, w1, w2, w3;
#define EXPN_(P, B, N) do { _Pragma("unroll") for (int e_ = 0; e_ < (N); ++e_) { P[(B) + e_] = fast_exp2(P[(B) + e_]); rs += P[(B) + e_]; } } while (0)
#define MF_(dst, a_, b_) dst = __builtin_amdgcn_mfma_f32_32x32x16_bf16(a_, b_, dst, 0, 0, 0)
    MF_(n0, ka[0], ka[2]); EXPN_(s0, 0, 2); SBAR_();
    MF_(n1, ka[1], ka[2]); DKF_(ka, 2); EXPN_(s0, 2, 2); w0.x = cvt_pk_bf16(s0[0], s0[1]); SBAR_();
    MF_(n0, kc[0], kc[2]); EXPN_(s0, 4, 2); w0.y = cvt_pk_bf16(s0[2], s0[3]); SBAR_();
    MF_(n1, kc[1], kc[2]); DKF_(kc, 3); EXPN_(s0, 6, 2); w0.z = cvt_pk_bf16(s0[4], s0[5]); SBAR_();
    MF_(n0, ka[0], ka[2]); EXPN_(s0, 8, 2); w0.w = cvt_pk_bf16(s0[6], s0[7]); SBAR_();
    MF_(n1, ka[1], ka[2]); EXPN_(s0, 10, 2); w1.x = cvt_pk_bf16(s0[8], s0[9]); SBAR_();
#pragma unroll
    for (int d = 0; d < 4; ++d) va[d] = DVF_(0, d);
    MF_(n0, kc[0], kc[2]); EXPN_(s0, 12, 2); w1.y = cvt_pk_bf16(s0[10], s0[11]); SBAR_();
    MF_(n1, kc[1], kc[2]); EXPN_(s0, 14, 2); w1.z = cvt_pk_bf16(s0[12], s0[13]); w1.w = cvt_pk_bf16(s0[14], s0[15]); SBAR_();
    vreg[0] = *(const u32x4*)vsrc; vreg[1] = *(const u32x4*)(vsrc + vstep);
    const bf16x8 pa0 = __builtin_bit_cast(bf16x8, w0), pa1 = __builtin_bit_cast(bf16x8, w1);
    SBAR_();
    MF_(o[0], pa0, va[0]); EXPN_(s1, 0, 2); SBAR_();
    MF_(o[1], pa0, va[1]); va[0] = DVF_(1, 0); va[1] = DVF_(1, 1); EXPN_(s1, 2, 2); w2.x = cvt_pk_bf16(s1[0], s1[1]); SBAR_();
    MF_(o[2], pa0, va[2]); va[2] = DVF_(1, 2); EXPN_(s1, 4, 2); w2.y = cvt_pk_bf16(s1[2], s1[3]); SBAR_();
    MF_(o[3], pa0, va[3]); va[3] = DVF_(1, 3); EXPN_(s1, 6, 2); w2.z = cvt_pk_bf16(s1[4], s1[5]); w2.w = cvt_pk_bf16(s1[6], s1[7]); SBAR_();
    MF_(o[0], pa1, va[0]); EXPN_(s1, 8, 2); SBAR_();
    MF_(o[1], pa1, va[1]); va[0] = DVF_(2, 0); va[1] = DVF_(2, 1); EXPN_(s1, 10, 2); w3.x = cvt_pk_bf16(s1[8], s1[9]); SBAR_();
    MF_(o[2], pa1, va[2]); va[2] = DVF_(2, 2); EXPN_(s1, 12, 2); w3.y = cvt_pk_bf16(s1[10], s1[11]); SBAR_();
    MF_(o[3], pa1, va[3]); va[3] = DVF_(2, 3); EXPN_(s1, 14, 2); w3.z = cvt_pk_bf16(s1[12], s1[13]); w3.w = cvt_pk_bf16(s1[14], s1[15]); SBAR_();
    lrun += rs;
    const bf16x8 pa2 = __builtin_bit_cast(bf16x8, w2), pa3 = __builtin_bit_cast(bf16x8, w3);
    float ra = fmaxf(fmaxf(n0[0], n0[1]), n1[0]), rb = fmaxf(fmaxf(n0[2], n0[3]), n1[1]);
    MF_(o[0], pa2, va[0]); ra = fmaxf(fmaxf(ra, n1[2]), n1[3]); rb = fmaxf(fmaxf(rb, n0[4]), n0[5]); SBAR_();
    MF_(o[1], pa2, va[1]); va[0] = DVF_(3, 0); va[1] = DVF_(3, 1); ra = fmaxf(fmaxf(ra, n0[6]), n0[7]); rb = fmaxf(fmaxf(rb, n1[4]), n1[5]); SBAR_();
    MF_(o[2], pa2, va[2]); va[2] = DVF_(3, 2); ra = fmaxf(fmaxf(ra, n1[6]), n1[7]); rb = fmaxf(fmaxf(rb, n0[8]), n0[9]); SBAR_();
    MF_(o[3], pa2, va[3]); va[3] = DVF_(3, 3); ra = fmaxf(fmaxf(ra, n0[10]), n0[11]); rb = fmaxf(fmaxf(rb, n1[8]), n1[9]); SBAR_();
    MF_(o[0], pa3, va[0]); ra = fmaxf(fmaxf(ra, n1[10]), n1[11]); rb = fmaxf(fmaxf(rb, n0[12]), n0[13]); SBAR_();
    MF_(o[1], pa3, va[1]); ra = fmaxf(fmaxf(ra, n0[14]), n0[15]); rb = fmaxf(fmaxf(rb, n1[12]), n1[13]); SBAR_();
    MF_(o[2], pa3, va[2]); ra = fmaxf(fmaxf(ra, n1[14]), n1[15]); SBAR_();
    MF_(o[3], pa3, va[3]);
#undef EXPN_
#undef MF_
#undef DVF_
#undef DKF_
    rmc = half_max(fmaxf(ra, rb));
}

__device__ __forceinline__ void diff_unit(const Params& P, int l, int b, int h, int qb, float lam, float lam_init, LAS unsigned char* lds, bool dry = false) {
    unsigned char* ws_ = launder_ptr(P.ws);
    const int tid = launder_tid(), lane = tid & 63, wid = __builtin_amdgcn_readfirstlane(tid >> 6), r32 = lane & 31, hi = lane >> 5;
    const int map = wid >> 2, wq = wid & 3;
    bf16_t* proj = (bf16_t*)(ws_ + WS_P);
    const size_t rowb = (size_t)b * SEQ; const int q0 = qb * 128;
    constexpr int BUFB = 37888, KOFF = 0, VOFF = 17408, DVS = 320;
    LAS float* wsf = (LAS float*)(lds + 2 * BUFB) + wid * 64;
    LAS float* bt = (LAS float*)(lds + 77824);
    LAS float* xch = (LAS float*)(lds + 79872);
    if (tid < 128) bt[tid] = P.in[I_REL][T5_BUCKET[tid] * 4 + h] * LOG2E;
    LAS unsigned char* qlds = lds + 79872 + wid * 4608 + r32 * 144 + hi * 16;
    { const bf16_t* Qw = proj + O_DQ + (rowb + q0 + wq * 32 + r32) * QP + h * 128 + map * 64;
#pragma unroll
      for (int d0 = 0; d0 < 4; ++d0) *(LAS bf16x8*)(qlds + d0 * 32) = *(const bf16x8*)(Qw + d0 * 16 + hi * 8); }
#define DIFF_QK(P0, P1, kt) do { bf16x8 qf[4]; _Pragma("unroll") for (int d0 = 0; d0 < 4; ++d0) qf[d0] = *(const LAS bf16x8*)(qlds + d0 * 32); attn_qk(P0, P1, kt, 272, qf, r32, hi); } while (0)
    f32x16 o[4];
#pragma unroll
    for (int d = 0; d < 4; ++d) o[d] = f32x16{};
    float mref = 0.f, lrun = 0.f;
    const int NT = 2 * (qb + 1);
    u32x4 kreg[2], vreg[2];
    const int srow = tid >> 4, sch = tid & 15;
    const bf16_t* sbase = proj + (rowb + srow) * QP + h * 128 + sch * 8;
#define DIFF_GLOADK(t) do { _Pragma("unroll") for (int i = 0; i < 2; ++i) kreg[i] = *(const u32x4*)(sbase + O_DK + (size_t)(64 * (t) + 32 * i) * QP); } while (0)
#define DIFF_GLOADV(t) do { _Pragma("unroll") for (int i = 0; i < 2; ++i) vreg[i] = *(const u32x4*)(sbase + O_DV + (size_t)(64 * (t) + 32 * i) * QP); } while (0)
#define DIFF_LSTOREK(buf) do { _Pragma("unroll") for (int i = 0; i < 2; ++i) *(LAS u32x4*)(lds + (buf) * BUFB + KOFF + (srow + 32 * i) * 272 + sch * 16) = kreg[i]; } while (0)
#define DIFF_LSTOREV(buf) do { _Pragma("unroll") for (int i = 0; i < 2; ++i) *(LAS u32x4*)(lds + (buf) * BUFB + VOFF + (srow + 32 * i) * DVS + sch * 16) = vreg[i]; } while (0)
    const int qme = q0 + wq * 32 + r32;
#define DIFF_INIT(P0, P1, t) do { const int qrel_ = qme - 64 * (t); \
        if (q0 + wq * 32 - (64 * (t) + 63) >= 113) { const float v_ = b31 - mref; _Pragma("unroll") for (int r = 0; r < 16; ++r) { P0[r] = v_; P1[r] = v_; } } \
        else { _Pragma("unroll") for (int r = 0; r < 16; ++r) { const int d0_ = qrel_ - crow(r, hi), d1_ = d0_ - 32; \
                 P0[r] = bt[min(max(d0_, 0), 127)] - mref; P1[r] = bt[min(max(d1_, 0), 127)] - mref; } } } while (0)
    DIFF_GLOADK(0); DIFF_GLOADV(0); DIFF_LSTOREK(0); DIFF_LSTOREV(0);
    DIFF_GLOADK(1); DIFF_LSTOREK(1);
    __syncthreads();
    const float b31 = bt[127];
    f32x16 s0, s1, n0 = {}, n1 = {};
    DIFF_INIT(s0, s1, 0); DIFF_QK(s0, s1, lds + KOFF + map * 128);
#define DIFF_ITER(t, S0, S1, N0, N1) do { \
        if ((t) + 2 < NT) DIFF_GLOADK((t) + 2); \
        if ((t) + 1 < NT) DIFF_GLOADV((t) + 1); \
        const int jb = (t) - (NT - 2); \
        const bool active = (jb < 0) || (jb <= (wq >> 1)); \
        const bool act_next = ((t) + 1 < NT) && ((jb + 1 < 0) || (jb + 1 <= (wq >> 1))); \
        if (act_next) { DIFF_INIT(N0, N1, (t) + 1); DIFF_QK(N0, N1, lds + (((t) + 1) & 1) * BUFB + KOFF + map * 128); } \
        if (active) { const bool domask = (jb >= 0) && (64 * jb + 63 > 32 * wq); \
            attn_sm_pv<4, 320>(S0, S1, N0, N1, act_next, lds + ((t) & 1) * BUFB + VOFF, o, mref, lrun, (t) == 0, domask, qme - 64 * (t), wsf, r32, hi); } \
        if ((t) + 2 < NT) DIFF_LSTOREK((t) & 1); \
        if ((t) + 1 < NT) DIFF_LSTOREV(((t) + 1) & 1); \
        __syncthreads(); } while (0)
#define DIFF_STEADY(t, S0, S1, N0, N1) do { \
        DIFF_GLOADK((t) + 2); \
        diff_steady_step(S0, S1, N0, N1, lds + (((t) + 1) & 1) * BUFB + KOFF + map * 128, lds + ((t) & 1) * BUFB + VOFF, qlds, o, mref, lrun, b31, wsf, r32, hi, rmc, sbase + O_DV + (size_t)(64 * ((t) + 1)) * QP, (size_t)32 * QP, vreg); \
        DIFF_LSTOREK((t) & 1); DIFF_LSTOREV(((t) + 1) & 1); \
        __syncthreads(); } while (0)
    DIFF_ITER(0, s0, s1, n0, n1);
    int t = 1;
    float rmc = 0.f;
    if (t + 1 <= NT - 6) rmc = rowmax32(n0, n1);
    for (; t + 1 <= NT - 6; t += 2) { DIFF_STEADY(t, n0, n1, s0, s1); DIFF_STEADY(t + 1, s0, s1, n0, n1); }
    for (; t + 1 < NT; t += 2) { DIFF_ITER(t, n0, n1, s0, s1); DIFF_ITER(t + 1, s0, s1, n0, n1); }
    DIFF_ITER(NT - 1, n0, n1, s0, s1);
#undef DIFF_STEADY
#undef DIFF_ITER
#undef DIFF_GLOADK
#undef DIFF_GLOADV
#undef DIFF_LSTOREK
#undef DIFF_LSTOREV
#undef DIFF_INIT
#undef DIFF_QK
    const float lt = half_sum(lrun);
    if (hi == 0) wsf[r32] = fast_rcp(lt) * (map ? lam : 1.0f);
    asm volatile("s_waitcnt lgkmcnt(0)" ::: "memory");
    float il[16];
#pragma unroll
    for (int r = 0; r < 16; ++r) il[r] = wsf[crow(r, hi)];
    if (map == 1) {
#pragma unroll
        for (int d = 0; d < 4; ++d)
#pragma unroll
            for (int r = 0; r < 16; ++r) xch[((wq * 4 + d) * 16 + r) * 64 + lane] = o[d][r] * il[r];
    }
    __syncthreads();
    if (map == 0) {
        float ssq[16];
#pragma unroll
        for (int r = 0; r < 16; ++r) ssq[r] = 0.f;
#pragma unroll
        for (int d = 0; d < 4; ++d)
#pragma unroll
            for (int r = 0; r < 16; ++r) { const float v = o[d][r] * il[r] - xch[((wq * 4 + d) * 16 + r) * 64 + lane]; o[d][r] = v; ssq[r] += v * v; }
#pragma unroll
        for (int r = 0; r < 16; ++r) {
#pragma unroll
            for (int s = 1; s < 32; s <<= 1) ssq[r] += __shfl_xor(ssq[r], s);
        }
        const float post = 1.0f - lam_init;
        float gsub[4];
#pragma unroll
        for (int d = 0; d < 4; ++d) gsub[d] = P.in[I_SUBG][l * 128 + 32 * d + r32] * post;
        bf16_t* Ow = proj + O_DQ + (rowb + q0 + wq * 32) * QP + h * 128;
#pragma unroll
        for (int r = 0; r < 16; ++r) { const int q = crow(r, hi); const float rstd = fast_rsq(ssq[r] * (1.0f / 128.0f) + EPS);
#pragma unroll
            for (int d = 0; d < 4; ++d) if (!dry || o[d][r] == 1.2345e30f) Ow[(size_t)q * QP + 32 * d + r32] = (bf16_t)f2bf(o[d][r] * rstd * gsub[d]); }
    }
    __syncthreads();
}

__device__ __forceinline__ void ffn_fixup(const Params& P, int l, int pm, int tid) {
    unsigned char* ws_ = launder_ptr(P.ws);
    const float* halo = (const float*)(ws_ + WS_HALO); bf16_t* act = (bf16_t*)(ws_ + WS_ACT);
    const float* cw = P.in[I_FCW] + (size_t)l * 3 * DFF2; const float* cb = P.in[I_FCB] + (size_t)l * DFF2;
    for (int it = tid; it < 4 * (DFF / 4); it += 512) {
        const int bi = it / (DFF / 4), ch0 = 4 * (it % (DFF / 4)); const int blk = pm * 4 + bi;
        const f32x4 z = {0.f, 0.f, 0.f, 0.f};
        f32x4 gm2 = z, gm1 = z, vm2 = z, vm1 = z;
        if ((blk & 31) != 0) { const float* hp = halo + ((size_t)(blk - 1) * 4 + 2) * DFF2 + ch0;
            gm2 = *(const f32x4*)hp; vm2 = *(const f32x4*)(hp + DFF); gm1 = *(const f32x4*)(hp + DFF2); vm1 = *(const f32x4*)(hp + DFF2 + DFF); }
        const float* hc = halo + ((size_t)blk * 4) * DFF2 + ch0;
        const f32x4 g0 = *(const f32x4*)hc, v0 = *(const f32x4*)(hc + DFF), g1 = *(const f32x4*)(hc + DFF2), v1 = *(const f32x4*)(hc + DFF2 + DFF);
        const f32x4 wg0 = *(const f32x4*)(cw + ch0), wg1 = *(const f32x4*)(cw + DFF2 + ch0), wg2 = *(const f32x4*)(cw + 2 * DFF2 + ch0), bg = *(const f32x4*)(cb + ch0);
        const f32x4 wv0 = *(const f32x4*)(cw + DFF + ch0), wv1 = *(const f32x4*)(cw + DFF2 + DFF + ch0), wv2 = *(const f32x4*)(cw + 2 * DFF2 + DFF + ch0), bv = *(const f32x4*)(cb + DFF + ch0);
        { const f32x4 cg = bg + wg0 * gm2 + wg1 * gm1 + wg2 * g0, cv = bv + wv0 * vm2 + wv1 * vm1 + wv2 * v0;
          u32x2 w; w.x = pk2(gelu_tanh(cg[0]) * cv[0], gelu_tanh(cg[1]) * cv[1]); w.y = pk2(gelu_tanh(cg[2]) * cv[2], gelu_tanh(cg[3]) * cv[3]);
          *(u32x2*)(act + (size_t)(blk * 64) * DFF + ch0) = w; }
        { const f32x4 cg = bg + wg0 * gm1 + wg1 * g0 + wg2 * g1, cv = bv + wv0 * vm1 + wv1 * v0 + wv2 * v1;
          u32x2 w; w.x = pk2(gelu_tanh(cg[0]) * cv[0], gelu_tanh(cg[1]) * cv[1]); w.y = pk2(gelu_tanh(cg[2]) * cv[2], gelu_tanh(cg[3]) * cv[3]);
          *(u32x2*)(act + (size_t)(blk * 64 + 1) * DFF + ch0) = w; }
    }
}

__device__ __forceinline__ void final_norm(float* x, const float* g, int gw, int NGW, int lane) {
    f32x4 gv[4];
#pragma unroll
    for (int j = 0; j < 4; ++j) gv[j] = ((const f32x4*)g)[lane + 64 * j];
    for (int m = gw; m < MTOK; m += NGW) {
        f32x4* xr = (f32x4*)(x + (size_t)m * DM) + lane;
        f32x4 v[4]; float ss = 0.f;
#pragma unroll
        for (int j = 0; j < 4; ++j) { v[j] = xr[64 * j]; ss += (v[j].x * v[j].x + v[j].y * v[j].y) + (v[j].z * v[j].z + v[j].w * v[j].w); }
        const float rstd = fast_rsq(wave_sum(ss) * (1.0f / DM) + EPS);
#pragma unroll
        for (int j = 0; j < 4; ++j) xr[64 * j] = v[j] * rstd * gv[j];
    }
}


#define XB_TMO      128
#define XB_XCNT(j)  (256  + 64 * (j))
#define XB_XSUB(j)  (1280 + 64 * (j))
#define XB_XGEN(j)  (2304 + 64 * (j))
#define XB_TOP      3328
#define XB_TOPGEN   3392
#define XCD_BAR_WORDS 3456
#define XB_SPIN_CAP (1u << 22)
__device__ __forceinline__ unsigned xb_ld(unsigned* p)              { return __hip_atomic_load(p, __ATOMIC_RELAXED, __HIP_MEMORY_SCOPE_AGENT); }
__device__ __forceinline__ unsigned xb_add(unsigned* p, unsigned v) { return __hip_atomic_fetch_add(p, v, __ATOMIC_RELAXED, __HIP_MEMORY_SCOPE_AGENT); }
__device__ __forceinline__ unsigned xb_xcc_id() { return (unsigned)__builtin_amdgcn_s_getreg((3 << 11) | 20) & 0xFu; }
#define XB_SPIN(cond, bar) do { unsigned _sp = 0; while (cond) { __builtin_amdgcn_s_sleep(1); \
    if ((++_sp & 255u) == 0u) { if (xb_ld(&(bar)[XB_TMO])) break; if (_sp > XB_SPIN_CAP) { atomicAdd(&(bar)[XB_TMO], 1u); break; } } } } while (0)
struct XcdBarrier { unsigned* bar; unsigned x; volatile LAS unsigned* st; };
__device__ __forceinline__ XcdBarrier xcd_barrier_post(unsigned* bar, volatile LAS unsigned* st) {
    XcdBarrier b; b.bar = bar; b.x = xb_xcc_id(); b.st = st;
    if (threadIdx.x == 0) (void)xb_add(&bar[XB_XCNT(b.x)], 1u);
    return b;
}
__device__ __forceinline__ void xcd_barrier_complete(unsigned* bar, unsigned x, unsigned& nloc, unsigned& nx) {
    const unsigned G = gridDim.x * gridDim.y * gridDim.z;
    unsigned sum, cnt, mine, sp = 0u;
    for (;;) {
        sum = 0u; cnt = 0u; mine = 0u;
#pragma unroll
        for (unsigned j = 0; j < 16; ++j) { const unsigned c = xb_ld(&bar[XB_XCNT(j)]); sum += c; cnt += (c > 0u) ? 1u : 0u; mine = (j == x) ? c : mine; }
        if (sum == G) break;
        __builtin_amdgcn_s_sleep(1);
        if ((++sp & 255u) == 0u) { if (xb_ld(&bar[XB_TMO])) break; if (sp > XB_SPIN_CAP) { atomicAdd(&bar[XB_TMO], 1u); break; } }
    }
    nloc = mine > 0u ? mine : 1u; nx = cnt > 0u ? cnt : 1u;
}
__device__ __forceinline__ void xcd_barrier(const XcdBarrier& b) {
    asm volatile("s_waitcnt vmcnt(0)" ::: "memory");
    __syncthreads();
    if (threadIdx.x == 0) {
        unsigned* bar = b.bar;
        __builtin_amdgcn_s_waitcnt(0);
        unsigned nloc = b.st[0], nx = b.st[1];
        if (nloc == 0u) { xcd_barrier_complete(bar, b.x, nloc, nx); b.st[0] = nloc; b.st[1] = nx; }
        const unsigned old = xb_add(&bar[XB_XSUB(b.x)], 1u);
        const unsigned gen = old / nloc;
        if (old + 1u == (gen + 1u) * nloc) {
            __builtin_amdgcn_fence(__ATOMIC_RELEASE, "agent");
            asm volatile("s_waitcnt vmcnt(0)" ::: "memory");
            const unsigned og = xb_add(&bar[XB_TOP], 1u);
            const unsigned tg = og / nx;
            if (og + 1u == (tg + 1u) * nx) xb_add(&bar[XB_TOPGEN], 1u);
            else XB_SPIN(xb_ld(&bar[XB_TOPGEN]) == tg, bar);
            __builtin_amdgcn_fence(__ATOMIC_ACQUIRE, "agent");
            xb_add(&bar[XB_XGEN(b.x)], 1u);
            asm volatile("s_waitcnt vmcnt(0)" ::: "memory");
        } else {
            XB_SPIN(xb_ld(&bar[XB_XGEN(b.x)]) == gen, bar);
            __builtin_amdgcn_fence(__ATOMIC_ACQUIRE, "agent");
            asm volatile("s_waitcnt vmcnt(0)" ::: "memory");
        }
    }
    __syncthreads();
}

#ifndef PHMASK
#define PHMASK 0xffffffffu
#endif
#define PH(n) ((PHMASK >> (n)) & 1u)
#ifndef PROBE_RG
#define PROBE_RG 0
#endif
#ifndef PROBE_DIFF
#define PROBE_DIFF 0
#endif
#ifndef PROBE_FOX
#define PROBE_FOX 0
#endif
#ifndef PROBE_SYNC
#define PROBE_SYNC 0
#endif
#ifndef PROBE_G1
#define PROBE_G1 0
#endif
__device__ __forceinline__ int launder_s(int v) { asm volatile("" : "+s"(v)); return v; }
#define PHASE_BEGIN { const int tid = launder_tid(); const int lane = tid & 63; const int wid = __builtin_amdgcn_readfirstlane(tid >> 6); \
    const int G = launder_s((int)gridDim.x), bx = launder_s((int)blockIdx.x); const int vcu = (G % 8 == 0) ? (bx % 8) * (G / 8) + bx / 8 : bx; \
    const int gw = vcu * 8 + wid, NGW = G * 8; unsigned char* ws = launder_ptr(P.ws); bf16_t* hbuf = (bf16_t*)(ws + WS_H); bf16_t* proj = (bf16_t*)(ws + WS_P); \
    float* xres = launder_ptr(P.out); const float* xin = (l == 0) ? launder_ptr(P.in[I_X]) : (const float*)xres; \
    (void)tid; (void)lane; (void)wid; (void)vcu; (void)gw; (void)NGW; (void)hbuf; (void)proj; (void)xin; (void)bx;
#define PHASE_END }
__global__ void __launch_bounds__(512, 2) fwd_megakernel(Params P) {
    extern __shared__ __attribute__((aligned(16))) unsigned char lds_raw[];
    LAS unsigned char* lds = (LAS unsigned char*)lds_raw;
    cg::grid_group grid = cg::this_grid();
    volatile LAS unsigned* bst = (volatile LAS unsigned*)(lds + LDS_BYTES - 64);
    if (threadIdx.x < 2) bst[threadIdx.x] = 0u;
    __syncthreads();
    (void)xcd_barrier_post((unsigned*)P.ws, bst);
#define GRID_SYNC() do { XcdBarrier xb_; xb_.bar = (unsigned*)launder_ptr(P.ws); xb_.x = xb_xcc_id(); xb_.st = (volatile LAS unsigned*)((LAS unsigned char*)lds_raw + LDS_BYTES - 64); xcd_barrier(xb_); } while (0)

    for (int l = 0; l < DEPTH; ++l) {
#if PH(1)
        PHASE_BEGIN
        convert_weights(P, l, lds, gw, NGW, wid, lane);
        __syncthreads();
        PHASE_END
#endif
#if PH(2)
        PHASE_BEGIN
        rmsnorm_rows<true>(xin, P.in[I_N1G] + l * DM, hbuf, P, l, lds, gw, NGW, lane);
        PHASE_END
#endif
        if (l == 0) grid.sync(); else GRID_SYNC();
#if PH(3)
        PHASE_BEGIN
        for (int b = bx; b < BATCH; b += G) cumsum_logf(P, b, wid, lane);
        for (int i = vcu * 512 + tid; i < MTOK; i += G * 512) ((float*)(ws + WS_SUMSQ))[i] = 0.f;
        PHASE_END
#endif
#if PH(4)
        PHASE_BEGIN
        pg8::Gemm g{hbuf, (const bf16_t*)(ws + WS_WIN), DM, DM, MTOK, 5120, DM}; pg8::StaticOrder S; S.init(MTOK, 5120, G, bx);
        pg8::EpiProj E{proj}; for (int rep = PROBE_G1; rep >= 0; --rep) pg8::gemm_phase(lds, g, S, E);
        for (int rep = 0; rep < PROBE_SYNC; ++rep) GRID_SYNC();
        PHASE_END
#endif
        GRID_SYNC();
#if PH(5)
        PHASE_BEGIN
        for (int rep = PROBE_RG; rep >= 0; --rep) for (int u = vcu; u < BATCH * 16; u += G) rglru_unit(P, l, u, lds, rep > 0);
        PHASE_END
#endif
#if PH(6)
        PHASE_BEGIN
            const float lam_init = (l == 0) ? 0.2f : 0.35550907f;
            float d1 = 0.f, d2 = 0.f;
            { const float* a1 = P.in[I_LQ1] + l * 64; const float* b1 = P.in[I_LK1] + l * 64; const float* a2 = P.in[I_LQ2] + l * 64; const float* b2 = P.in[I_LK2] + l * 64;
              d1 = wave_sum(a1[lane] * b1[lane]); d2 = wave_sum(a2[lane] * b2[lane]); }
            const float lam = fast_exp2(d1 * LOG2E) - fast_exp2(d2 * LOG2E) + lam_init;
            for (int rep = PROBE_DIFF; rep >= 0; --rep) for (int p = vcu; p < BATCH * 4 * 8; p += G) { const int bh = p >> 3, s = p & 7;
                diff_unit(P, l, bh >> 2, bh & 3, s, lam, lam_init, lds, rep > 0); diff_unit(P, l, bh >> 2, bh & 3, 15 - s, lam, lam_init, lds, rep > 0); }
        PHASE_END
#endif
#if PH(7)
        PHASE_BEGIN
        for (int rep = PROBE_FOX; rep >= 0; --rep) for (int p = vcu; p < BATCH * 8 * 4; p += G) { const int bh = p >> 2, s = p & 3;
            fox_unit(P, bh >> 3, bh & 7, s, lds, rep > 0); fox_unit(P, bh >> 3, bh & 7, 7 - s, lds, rep > 0); }
        PHASE_END
#endif
        GRID_SYNC();
#if PH(8)
        PHASE_BEGIN
        pg8::Gemm g{hbuf, (const bf16_t*)(ws + WS_WIN) + (size_t)5120 * DM, DM, DM, MTOK, 3072, DM}; pg8::StaticOrder S; S.init(MTOK, 3072, G, bx);
        pg8::EpiGates E{proj, P.in[I_GATEB] + l * 3072}; pg8::gemm_phase(lds, g, S, E);
        PHASE_END
#endif
        GRID_SYNC();
#if PH(9)
        PHASE_BEGIN
        pg8::StaticOrder S; S.init(MTOK, DM, G, bx);
        static_assert(WS_WBR_DIFF == WS_WBR_RNN + 2 * MiB && WS_WBR_FOX == WS_WBR_RNN + 4 * MiB, "Gemm3 segment arithmetic");
        pg8::Gemm3 g{proj, (const bf16_t*)(ws + WS_WBR_RNN), DM};
        pg8::EpiMerge3 E{proj, hbuf}; pg8::gemm_phase3(lds, g, S, E);
        PHASE_END
#endif
        GRID_SYNC();
#if PH(10)
        PHASE_BEGIN
        pg8::Gemm g{hbuf, (const bf16_t*)(ws + WS_WOUT), DM, DM, MTOK, DM, DM}; pg8::StaticOrder S; S.init(MTOK, DM, G, bx);
        pg8::EpiResidNorm E{xin, xres, (bf16_t*)(ws + WS_XG), P.in[I_N2G] + l * DM, (float*)(ws + WS_SUMSQ)}; pg8::gemm_phase(lds, g, S, E);
        PHASE_END
#endif
        GRID_SYNC();
#if PH(12)
        PHASE_BEGIN
        pg8::Gemm g{(const bf16_t*)(ws + WS_XG), (const bf16_t*)(ws + WS_WUP), DM, DM, MTOK, DFF2, DM}; pg8::StaticOrder S; S.init(MTOK, DFF2, G, bx);
        pg8::EpiFfn E{(bf16_t*)(ws + WS_ACT), (float*)(ws + WS_HALO), P.in[I_FCW] + (size_t)l * 3 * DFF2, P.in[I_FCB] + (size_t)l * DFF2, (const float*)(ws + WS_SUMSQ)};
        pg8::gemm_phase(lds, g, S, E);
        PHASE_END
#endif
        GRID_SYNC();
#if PH(14)
        PHASE_BEGIN
        pg8::StaticOrder S; S.init(MTOK, DM, G, bx);
        { pg8::Unit u; for (int i = 0; S.next(i, u); ++i) ffn_fixup(P, l, u.pm, tid); }
        asm volatile("s_waitcnt vmcnt(0)" ::: "memory"); __syncthreads();
        pg8::Gemm g{(const bf16_t*)(ws + WS_ACT), (const bf16_t*)(ws + WS_WDOWN), DFF, DFF, MTOK, DM, DFF};
        pg8::EpiResid E{xres, xres, 0}; pg8::gemm_phase(lds, g, S, E);
        PHASE_END
#endif
        GRID_SYNC();
    }
#if PH(15)
    { const int l = 1; PHASE_BEGIN
    final_norm(xres, P.in[I_FINALG], gw, NGW, lane);
    PHASE_END }
#endif
}

extern "C" void kernel_launch(void* const* d_in, const int* in_sizes, int n_in, void* d_out, int out_size, void* d_ws, size_t ws_size, hipStream_t stream) {
    static int grid = 0;
    if (grid == 0) {
        if (n_in != 28 || in_sizes[0] != MTOK * DM || out_size != MTOK * DM || ws_size < WS_END) {
            fprintf(stderr, "kernel_launch: unexpected shapes (n_in %d, in0 %d, out %d, ws %zu)\n", n_in, n_in > 0 ? in_sizes[0] : -1, out_size, ws_size); grid = -1; return; }
        int dev = 0, cus = 0, per_cu = 0;
        hipGetDevice(&dev); hipDeviceGetAttribute(&cus, hipDeviceAttributeMultiprocessorCount, dev);
        if (hipFuncSetAttribute((const void*)fwd_megakernel, hipFuncAttributeMaxDynamicSharedMemorySize, LDS_BYTES) != hipSuccess) { fprintf(stderr, "hipFuncSetAttribute failed\n"); grid = -1; return; }
        if (hipOccupancyMaxActiveBlocksPerMultiprocessor(&per_cu, (const void*)fwd_megakernel, 512, LDS_BYTES) != hipSuccess || per_cu < 1) per_cu = 1;
        (void)hipGetLastError();
        grid = cus * per_cu;
    }
    if (grid < 0) return;
    if (hipMemsetAsync(d_ws, 0, 16384, stream) != hipSuccess) { fprintf(stderr, "memset failed\n"); return; }
    Params p{};
    for (int i = 0; i < 28; ++i) p.in[i] = (const float*)d_in[i];
    p.out = (float*)d_out; p.ws = (unsigned char*)d_ws;
    void* args[] = {&p};
    hipError_t e = hipLaunchCooperativeKernel((const void*)fwd_megakernel, dim3(grid), dim3(512), args, LDS_BYTES, stream);
    if (e != hipSuccess) fprintf(stderr, "cooperative launch failed: %s (grid %d)\n", hipGetErrorString(e), grid);
}
```
